# Optimizing an MI355X kernel written in HIP

```python
import math
import jax
import jax.numpy as jnp
from jax import lax
import numpy as np

D_MODEL = 1024
BATCH = 16
SEQ = 2048
DEPTH = 4

GRID_W = 64
CTX_LEN = 256
N_MIXERS = 3
N_HYENA = (DEPTH + 2) // 3
N_S5 = (DEPTH + 1) // 3
N_MLSTM = DEPTH // 3
EPS = 1e-6

HY_CONV = 3
HY_EMB = 33
HY_BANDS = (HY_EMB - 1) // 2
HY_ORDER = 64
HY_FAST_DECAY = 0.3
HY_SLOW_DECAY = 1.5
HY_TARGET = 1e-2

S5_GROUP = 16
S5_GROUPS = D_MODEL // S5_GROUP
S5_STATE = 64
SCAN_CHUNK = 128

ML_INNER = 2 * D_MODEL
ML_HEADS = 4
ML_HEAD_DIM = ML_INNER // ML_HEADS
ML_QKV_BLOCK = 4
ML_CONV = 3
ML_CHUNK = 64

N_EXPERTS = 32
TOP_K = 4
D_EXPERT = D_MODEL
SWIGLU_LIMIT = 7.0
SWIGLU_ALPHA = 1.702
MOE_BLOCK = 512

kernel_name = 'hybrid_hyena_s5_mlstm_moe_dit'


def _rmsnorm(x, g):
    xf = x.astype(jnp.float32)
    y = xf * lax.rsqrt(jnp.mean(xf * xf, axis=-1, keepdims=True) + EPS)
    return (y * g.astype(jnp.float32)).astype(x.dtype)


def _flip(t, rev):
    return t[:, ::-1] if rev else t


def _dwconv(u, w, b):
    width = w.shape[0]
    pad = width // 2
    L = u.shape[1]
    up = jnp.pad(u, ((0, 0), (pad, pad), (0, 0)))
    out = up[:, 0:L] * w[0]
    for j in range(1, width):
        out = out + up[:, j:j + L] * w[j]
    return out + b


def _blockdiag(x, w):
    bsz, L, _ = x.shape
    nb, bs, _ = w.shape
    return jnp.einsum('blni,nio->blno', x.reshape(bsz, L, nb, bs), w).reshape(bsz, L, nb * bs)


def _hyena_filter(L, f_w1, f_b1, f_w2, f_b2, f_w3, f_freq):
    f32 = jnp.float32
    d = f_w3.shape[1] // 2
    t = jnp.linspace(0.0, 1.0, L, dtype=f32)[:, None]
    w = (2.0 * math.pi / L) * jnp.arange(L, dtype=f32)[:, None]
    f = jnp.linspace(1e-4, HY_BANDS - 1, HY_BANDS, dtype=f32)[None, :]
    z = jnp.concatenate([t, jnp.cos(f * w), -jnp.sin(f * w)], axis=-1)
    freq = f_freq.astype(f32)
    hid = jnp.sin(freq * (z @ f_w1.astype(f32) + f_b1.astype(f32)))
    hid = jnp.sin(freq * (hid @ f_w2.astype(f32) + f_b2.astype(f32)))
    filt = hid @ f_w3.astype(f32)
    deltas = jnp.abs(jnp.linspace(math.log(HY_FAST_DECAY) / HY_TARGET,
                                  math.log(HY_SLOW_DECAY) / HY_TARGET, d, dtype=f32))
    decay = jnp.exp(-t * deltas)
    fwd = filt[:, :d] * decay
    bwd = filt[:, d:] * decay
    full = jnp.concatenate([fwd, jnp.zeros((1, d), f32), bwd[:0:-1]], axis=0)
    return full / jnp.sum(jnp.abs(full), axis=0, keepdims=True)


def _hyena(h, w_in, b_in, conv_w, conv_b, f_w1, f_b1, f_w2, f_b2, f_w3, f_freq, f_bias, w_out, b_out):
    L = h.shape[1]
    u = _dwconv(h @ w_in + b_in, conv_w, conv_b)
    x0, x1, v = jnp.split(u, 3, axis=-1)
    z = (v * x1).astype(jnp.float32)
    filt = _hyena_filter(L, f_w1, f_b1, f_w2, f_b2, f_w3, f_freq)
    zf = jnp.fft.rfft(z, n=2 * L, axis=1)
    ff = jnp.fft.rfft(filt, n=2 * L, axis=0)
    y = jnp.fft.irfft(zf * ff[None], n=2 * L, axis=1)[:, :L] + z * f_bias.astype(jnp.float32)
    y = y.astype(h.dtype) * x0
    return y @ w_out + b_out


def _lin_combine(e1, e2):
    a1, b1 = e1
    a2, b2 = e2
    return a1 * a2, a2 * b1 + b2


def _s5_scan(u, lam_bar, b_bar, c_mat, st0, with_out):
    bsz, L, _ = u.shape
    n = L // SCAN_CHUNK
    ub = jnp.moveaxis(u.astype(jnp.float32).reshape(bsz, n, SCAN_CHUNK, S5_GROUPS, S5_GROUP), 1, 0)

    def step(st, u_blk):
        bu = jnp.einsum('btgh,gph->btgp', u_blk.astype(jnp.complex64), b_bar)
        bu = bu.at[:, 0].add(lam_bar * st)
        _, states = lax.associative_scan(_lin_combine, (jnp.broadcast_to(lam_bar, bu.shape), bu), axis=1)
        y = jnp.einsum('btgp,ghp->btgh', states, c_mat).real if with_out else None
        return states[:, -1], y

    st, y = lax.scan(step, st0, ub)
    if with_out:
        y = jnp.moveaxis(y, 0, 1).reshape(bsz, L, S5_GROUPS * S5_GROUP)
    return y, st


def _s5(h_ctx, h_lat, a_re, a_im, log_step, b_re, b_im, c_re, c_im, d_skip, w1, b1, w2, b2, ctx_out):
    f32 = jnp.float32
    bsz = h_lat.shape[0]
    outs_c, outs_l = [], []
    for dr in range(2):
        rev = dr == 1
        lam = lax.complex(a_re[dr].astype(f32), a_im[dr].astype(f32))
        lam_bar = jnp.exp(lam * jnp.exp(log_step[dr].astype(f32))[:, None])
        b_bar = ((lam_bar - 1.0) / lam)[..., None] * lax.complex(b_re[dr].astype(f32), b_im[dr].astype(f32))
        c_mat = lax.complex(c_re[dr].astype(f32), c_im[dr].astype(f32))
        st0 = jnp.zeros((bsz, S5_GROUPS, S5_STATE), jnp.complex64)
        yc, st = _s5_scan(_flip(h_ctx, rev), lam_bar, b_bar, c_mat, st0, ctx_out)
        yl, _ = _s5_scan(_flip(h_lat, rev), lam_bar, b_bar, c_mat, st, True)
        outs_l.append(_flip(yl, rev))
        if ctx_out:
            outs_c.append(_flip(yc, rev))

    def finish(y, h):
        y = jax.nn.gelu(y + d_skip.astype(f32) * h.astype(f32)).astype(h.dtype)
        return (y @ w1 + b1) * jax.nn.sigmoid(y @ w2 + b2)

    y_lat = finish(outs_l[0] + outs_l[1], h_lat)
    y_ctx = finish(outs_c[0] + outs_c[1], h_ctx) if ctx_out else None
    return y_ctx, y_lat


def _mlstm_scan(q, k, v, ig, fg, carry, with_out):
    bsz, L, nh, dh = q.shape
    n = L // ML_CHUNK

    def blocks(t):
        return jnp.moveaxis(t.reshape((bsz, n, ML_CHUNK) + t.shape[2:]), (1, 2), (0, 3))

    tril = jnp.tril(jnp.ones((ML_CHUNK, ML_CHUNK), dtype=bool))

    def step(carry, blk):
        c_mat, n_vec, m = carry
        qb, kb, vb, ib, fb = blk
        b = jnp.cumsum(jax.nn.log_sigmoid(fb), axis=-1)
        b_tot = b[..., -1]
        w_log = b_tot[..., None] - b + ib
        m_new = jnp.maximum(b_tot + m, jnp.max(w_log, axis=-1))
        w_in = jnp.exp(w_log - m_new[..., None])
        dec = jnp.exp(b_tot + m - m_new)
        c_new = dec[..., None, None] * c_mat + jnp.einsum('bhsd,bhse->bhde', w_in[..., None] * kb, vb)
        n_new = dec[..., None] * n_vec + jnp.einsum('bhs,bhsd->bhd', w_in, kb)
        if not with_out:
            return (c_new, n_new, m_new), None
        log_d = jnp.where(tril, b[..., :, None] - b[..., None, :] + ib[..., None, :], -jnp.inf)
        inter = b + m[..., None]
        m_row = jnp.maximum(inter, jnp.max(log_d, axis=-1))
        s = jnp.einsum('bhtd,bhsd->bhts', qb, kb) * jnp.exp(log_d - m_row[..., None])
        w_prev = jnp.exp(inter - m_row)
        num = w_prev[..., None] * jnp.einsum('bhtd,bhde->bhte', qb, c_mat) + jnp.einsum('bhts,bhse->bhte', s, vb)
        den = w_prev * jnp.einsum('bhtd,bhd->bht', qb, n_vec) + jnp.sum(s, axis=-1)
        hb = num / jnp.maximum(jnp.abs(den), jnp.exp(-m_row))[..., None]
        return (c_new, n_new, m_new), hb

    carry, hs = lax.scan(step, carry, tuple(blocks(t) for t in (q, k, v, ig, fg)))
    if with_out:
        hs = jnp.moveaxis(hs, (0, 3), (1, 2)).reshape(bsz, L, nh * dh)
    return hs, carry


def _head_layernorm(h, g):
    bsz, L, _ = h.shape
    hh = h.reshape(bsz, L, ML_HEADS, ML_HEAD_DIM)
    mu = jnp.mean(hh, axis=-1, keepdims=True)
    var = jnp.mean(jnp.square(hh - mu), axis=-1, keepdims=True)
    return ((hh - mu) * lax.rsqrt(var + EPS)).reshape(bsz, L, -1) * g.astype(jnp.float32)


def _mlstm(h_ctx, h_lat, w_up, conv_w, conv_b, w_q, w_k, w_v, ig_w, ig_b, fg_w, fg_b, onorm_g, skip, w_down, ctx_out):
    f32 = jnp.float32

    def project(h):
        bsz, L, _ = h.shape
        xm = h @ w_up[:, :ML_INNER]
        xc = jax.nn.silu(_dwconv(xm, conv_w, conv_b))
        q, k, v = _blockdiag(xc, w_q), _blockdiag(xc, w_k), _blockdiag(xm, w_v)
        qkv = jnp.concatenate([q, k, v], axis=-1)
        heads = lambda t: t.astype(f32).reshape(bsz, L, ML_HEADS, ML_HEAD_DIM)
        igs = [(qkv @ ig_w[dr] + ig_b[dr]).astype(f32) for dr in range(2)]
        fgs = [(qkv @ fg_w[dr] + fg_b[dr]).astype(f32) for dr in range(2)]
        return xc, (heads(q), heads(k) * ML_HEAD_DIM ** -0.5, heads(v)), igs, fgs

    def finish(hsum, h, xc):
        hn = _head_layernorm(hsum, onorm_g).astype(h.dtype)
        z = h @ w_up[:, ML_INNER:]
        return ((hn + skip * xc) * jax.nn.silu(z)) @ w_down

    xc_c, qkv_c, ig_c, fg_c = project(h_ctx)
    xc_l, qkv_l, ig_l, fg_l = project(h_lat)
    bsz = h_lat.shape[0]
    outs_c, outs_l = [], []
    for dr in range(2):
        rev = dr == 1
        carry = (jnp.zeros((bsz, ML_HEADS, ML_HEAD_DIM, ML_HEAD_DIM), f32),
                 jnp.zeros((bsz, ML_HEADS, ML_HEAD_DIM), f32),
                 jnp.zeros((bsz, ML_HEADS), f32))
        hc, carry = _mlstm_scan(*[_flip(t, rev) for t in (*qkv_c, ig_c[dr], fg_c[dr])], carry, ctx_out)
        hl, _ = _mlstm_scan(*[_flip(t, rev) for t in (*qkv_l, ig_l[dr], fg_l[dr])], carry, True)
        outs_l.append(_flip(hl, rev))
        if ctx_out:
            outs_c.append(_flip(hc, rev))
    y_lat = finish(outs_l[0] + outs_l[1], h_lat, xc_l)
    y_ctx = finish(outs_c[0] + outs_c[1], h_ctx, xc_c) if ctx_out else None
    return y_ctx, y_lat


def _moe(h, router_w, router_b, w_gu, b_gu, w_down, b_down):
    n_tok = h.shape[0]
    logits = (h @ router_w + router_b).astype(jnp.float32)
    top_val, top_idx = lax.top_k(logits, TOP_K)
    gate = jax.nn.softmax(top_val, axis=-1)
    n_rows = n_tok * TOP_K
    n_blocks = -(-n_rows // MOE_BLOCK) + N_EXPERTS
    flat_e = top_idx.reshape(-1)
    order = jnp.argsort(flat_e)
    sorted_e = flat_e[order]
    counts = jnp.bincount(flat_e, length=N_EXPERTS)
    padded = (counts + MOE_BLOCK - 1) // MOE_BLOCK * MOE_BLOCK
    pad_end = jnp.cumsum(padded)
    rank = jnp.arange(n_rows) - (jnp.cumsum(counts) - counts)[sorted_e]
    dest = (pad_end - padded)[sorted_e] + rank
    slot_tok = jnp.full((n_blocks * MOE_BLOCK,), n_tok, jnp.int32).at[dest].set((order // TOP_K).astype(jnp.int32))
    slot_gate = jnp.zeros((n_blocks * MOE_BLOCK,), jnp.float32).at[dest].set(gate.reshape(-1)[order])
    block_e = jnp.minimum(jnp.searchsorted(pad_end, jnp.arange(n_blocks) * MOE_BLOCK, side='right'), N_EXPERTS - 1)

    def step(out, blk):
        tok, g, e = blk
        xb = h[jnp.minimum(tok, n_tok - 1)]
        gu = xb @ w_gu[e] + b_gu[e]
        gt = jnp.minimum(gu[:, 0::2], SWIGLU_LIMIT)
        up = jnp.clip(gu[:, 1::2], -SWIGLU_LIMIT, SWIGLU_LIMIT)
        yb = ((up + 1.0) * gt * jax.nn.sigmoid(SWIGLU_ALPHA * gt)) @ w_down[e] + b_down[e]
        return out.at[tok].add((yb * g[:, None]).astype(out.dtype), mode='drop'), None

    out, _ = lax.scan(step, jnp.zeros_like(h),
                      (slot_tok.reshape(n_blocks, MOE_BLOCK), slot_gate.reshape(n_blocks, MOE_BLOCK), block_e))
    return out


def setup_inputs(seed: int = 0) -> dict:
    key = jax.random.key(seed)
    keys = iter(jax.random.split(key, 96))

    def nrm(shape, scale):
        return jax.random.normal(next(keys), shape, jnp.float32) * scale

    def gain(shape):
        return 1.0 + nrm(shape, 0.02)

    D, E, F = D_MODEL, N_EXPERTS, D_EXPERT
    G, P, H = S5_GROUPS, S5_STATE, S5_GROUP
    I = ML_INNER
    return {
        'x': nrm((BATCH, SEQ, D), 1.0),
        'c': nrm((BATCH, D), 1.0),
        'ctx': nrm((BATCH, CTX_LEN, D), 1.0),
        'c_ctx': nrm((D,), 1.0),
        'ada_w': nrm((DEPTH, D, 6 * D), 0.5 * D ** -0.5),
        'ada_b': nrm((DEPTH, 6 * D), 0.02),
        'norm1_g': gain((DEPTH, D)),
        'norm2_g': gain((DEPTH, D)),
        'router_w': nrm((DEPTH, D, E), D ** -0.5),
        'router_b': nrm((DEPTH, E), 0.01),
        'moe_w_gu': nrm((DEPTH, E, D, 2 * F), D ** -0.5),
        'moe_b_gu': nrm((DEPTH, E, 2 * F), 0.01),
        'moe_w_down': nrm((DEPTH, E, F, D), F ** -0.5),
        'moe_b_down': nrm((DEPTH, E, D), 0.01),
        'hy_w_in': nrm((N_HYENA, D, 3 * D), D ** -0.5),
        'hy_b_in': nrm((N_HYENA, 3 * D), 0.01),
        'hy_conv_w': nrm((N_HYENA, HY_CONV, 3 * D), HY_CONV ** -0.5),
        'hy_conv_b': nrm((N_HYENA, 3 * D), 0.01),
        'hy_f_w1': nrm((N_HYENA, HY_EMB, HY_ORDER), HY_EMB ** -0.5),
        'hy_f_b1': nrm((N_HYENA, HY_ORDER), 0.1),
        'hy_f_w2': nrm((N_HYENA, HY_ORDER, HY_ORDER), HY_ORDER ** -0.5),
        'hy_f_b2': nrm((N_HYENA, HY_ORDER), 0.1),
        'hy_f_w3': nrm((N_HYENA, HY_ORDER, 2 * D), HY_ORDER ** -0.5),
        'hy_f_freq': gain((N_HYENA, HY_ORDER)),
        'hy_f_bias': nrm((N_HYENA, D), 1.0),
        'hy_w_out': nrm((N_HYENA, D, D), D ** -0.5),
        'hy_b_out': nrm((N_HYENA, D), 0.01),
        's5_a_re': -0.5 + nrm((N_S5, 2, G, P), 0.01),
        's5_a_im': jnp.broadcast_to(math.pi * jnp.arange(P, dtype=jnp.float32), (N_S5, 2, G, P)),
        's5_log_step': jax.random.uniform(next(keys), (N_S5, 2, G), jnp.float32,
                                          minval=math.log(1e-3), maxval=math.log(1e-1)),
        's5_b_re': nrm((N_S5, 2, G, P, H), (2 * H) ** -0.5),
        's5_b_im': nrm((N_S5, 2, G, P, H), (2 * H) ** -0.5),
        's5_c_re': nrm((N_S5, 2, G, H, P), P ** -0.5),
        's5_c_im': nrm((N_S5, 2, G, H, P), P ** -0.5),
        's5_d': nrm((N_S5, D), 1.0),
        's5_glu_w1': nrm((N_S5, D, D), D ** -0.5),
        's5_glu_b1': nrm((N_S5, D), 0.01),
        's5_glu_w2': nrm((N_S5, D, D), D ** -0.5),
        's5_glu_b2': nrm((N_S5, D), 0.01),
        'ml_w_up': nrm((N_MLSTM, D, 2 * I), D ** -0.5),
        'ml_conv_w': nrm((N_MLSTM, ML_CONV, I), ML_CONV ** -0.5),
        'ml_conv_b': nrm((N_MLSTM, I), 0.01),
        'ml_w_q': nrm((N_MLSTM, I // ML_QKV_BLOCK, ML_QKV_BLOCK, ML_QKV_BLOCK), ML_QKV_BLOCK ** -0.5),
        'ml_w_k': nrm((N_MLSTM, I // ML_QKV_BLOCK, ML_QKV_BLOCK, ML_QKV_BLOCK), ML_QKV_BLOCK ** -0.5),
        'ml_w_v': nrm((N_MLSTM, I // ML_QKV_BLOCK, ML_QKV_BLOCK, ML_QKV_BLOCK), ML_QKV_BLOCK ** -0.5),
        'ml_ig_w': nrm((N_MLSTM, 2, 3 * I, ML_HEADS), 0.1 * (3 * I) ** -0.5),
        'ml_ig_b': nrm((N_MLSTM, 2, ML_HEADS), 0.1),
        'ml_fg_w': nrm((N_MLSTM, 2, 3 * I, ML_HEADS), 0.1 * (3 * I) ** -0.5),
        'ml_fg_b': jnp.linspace(3.0, 6.0, ML_HEADS, dtype=jnp.float32) + nrm((N_MLSTM, 2, ML_HEADS), 0.1),
        'ml_onorm_g': gain((N_MLSTM, I)),
        'ml_skip': gain((N_MLSTM, I)),
        'ml_w_down': nrm((N_MLSTM, I, D), I ** -0.5),
        'final_norm_g': gain((D,)),
    }


def reference(x, c, ctx, c_ctx, ada_w, ada_b, norm1_g, norm2_g, router_w, router_b,
              moe_w_gu, moe_b_gu, moe_w_down, moe_b_down,
              hy_w_in, hy_b_in, hy_conv_w, hy_conv_b, hy_f_w1, hy_f_b1, hy_f_w2, hy_f_b2,
              hy_f_w3, hy_f_freq, hy_f_bias, hy_w_out, hy_b_out,
              s5_a_re, s5_a_im, s5_log_step, s5_b_re, s5_b_im, s5_c_re, s5_c_im, s5_d,
              s5_glu_w1, s5_glu_b1, s5_glu_w2, s5_glu_b2,
              ml_w_up, ml_conv_w, ml_conv_b, ml_w_q, ml_w_k, ml_w_v, ml_ig_w, ml_ig_b,
              ml_fg_w, ml_fg_b, ml_onorm_g, ml_skip, ml_w_down,
              final_norm_g):
    bsz, seq, d = x.shape
    n_ctx = ctx.shape[1]
    rows = seq // GRID_W
    sc_lat = jax.nn.silu(c)
    sc_ctx = jax.nn.silu(c_ctx)[None]
    for i in range(DEPTH):
        kind, j = i % N_MIXERS, i // N_MIXERS
        ctx_live = any(l % N_MIXERS != 0 for l in range(i + 1, DEPTH))
        need_hc = ctx_live or kind != 0
        mod = jnp.split((sc_lat @ ada_w[i] + ada_b[i])[:, None, :], 6, axis=-1)
        h = _rmsnorm(x, norm1_g[i]) * (1 + mod[1]) + mod[0]
        if need_hc:
            mod_c = jnp.split((sc_ctx @ ada_w[i] + ada_b[i])[:, None, :], 6, axis=-1)
            hc = _rmsnorm(ctx, norm1_g[i]) * (1 + mod_c[1]) + mod_c[0]
        if kind == 0:
            hp = (hy_w_in[j], hy_b_in[j], hy_conv_w[j], hy_conv_b[j], hy_f_w1[j], hy_f_b1[j],
                  hy_f_w2[j], hy_f_b2[j], hy_f_w3[j], hy_f_freq[j], hy_f_bias[j], hy_w_out[j], hy_b_out[j])
            y = _hyena(h, *hp)
            yc = _hyena(hc, *hp) if ctx_live else None
        elif kind == 1:
            yc, y = _s5(hc, h, s5_a_re[j], s5_a_im[j], s5_log_step[j], s5_b_re[j], s5_b_im[j],
                        s5_c_re[j], s5_c_im[j], s5_d[j], s5_glu_w1[j], s5_glu_b1[j],
                        s5_glu_w2[j], s5_glu_b2[j], ctx_live)
        else:
            h_cm = h.reshape(bsz, rows, GRID_W, d).transpose(0, 2, 1, 3).reshape(bsz, seq, d)
            yc, y_cm = _mlstm(hc, h_cm, ml_w_up[j], ml_conv_w[j], ml_conv_b[j], ml_w_q[j], ml_w_k[j],
                              ml_w_v[j], ml_ig_w[j], ml_ig_b[j], ml_fg_w[j], ml_fg_b[j],
                              ml_onorm_g[j], ml_skip[j], ml_w_down[j], ctx_live)
            y = y_cm.reshape(bsz, GRID_W, rows, d).transpose(0, 2, 1, 3).reshape(bsz, seq, d)
        x = x + mod[2] * y
        h2 = _rmsnorm(x, norm2_g[i]) * (1 + mod[4]) + mod[3]
        mp = (router_w[i], router_b[i], moe_w_gu[i], moe_b_gu[i], moe_w_down[i], moe_b_down[i])
        if ctx_live:
            ctx = ctx + mod_c[2] * yc
            hc2 = _rmsnorm(ctx, norm2_g[i]) * (1 + mod_c[4]) + mod_c[3]
            out = _moe(jnp.concatenate([hc2.reshape(-1, d), h2.reshape(-1, d)], axis=0), *mp)
            ctx = ctx + mod_c[5] * out[:bsz * n_ctx].reshape(ctx.shape)
            x = x + mod[5] * out[bsz * n_ctx:].reshape(x.shape)
        else:
            x = x + mod[5] * _moe(h2.reshape(-1, d), *mp).reshape(x.shape)
    return _rmsnorm(x, final_norm_g)
```

```cpp
#ifdef CPU_EMU
#include "emu.h"
#else
#include <hip/hip_runtime.h>
#endif
#include <stdint.h>
#include <stddef.h>

#ifndef DM
#define DM 1024
#define BATCH 16
#define SEQ 2048
#define GRID_W 64
#define CTX_LEN 256
#endif
#ifndef N_LAUNCH_MODE
#define N_LAUNCH_MODE 1
#endif

#ifndef PROBE_GROUP
#define PROBE_GROUP 0
#endif
#ifndef PROBE_ABL
#define PROBE_ABL 0
#endif
#define DEV __device__ __forceinline__
typedef unsigned short bf16_t;
typedef short bf16x8 __attribute__((ext_vector_type(8)));
typedef float f32x4 __attribute__((ext_vector_type(4)));
typedef float f32x2 __attribute__((ext_vector_type(2)));
typedef unsigned u32x4 __attribute__((ext_vector_type(4)));
typedef unsigned u32x2 __attribute__((ext_vector_type(2)));

constexpr int NE = 32, TOPK = 4, DEPTH = 4;
constexpr int NCTX = BATCH * CTX_LEN, NLAT = BATCH * SEQ, NTOK = NCTX + NLAT;
constexpr int ROWS_G = SEQ / GRID_W;
constexpr int DI = 2 * DM, NH = 4, DH = DI / NH;
constexpr int S5G = DM / 16;
constexpr int NT = 512;
constexpr int NMODR = BATCH + 1;
constexpr int FF = DM;
constexpr int HY_ORDER = 64, HY_EMB = 33;
constexpr float EPS = 1e-6f;
constexpr int MOE_BM = 256;
constexpr int NSLOT = NTOK * TOPK + NE * MOE_BM;

enum { I_X, I_C, I_CTX, I_CCTX, I_ADAW, I_ADAB, I_N1G, I_N2G, I_RW, I_RB, I_WGU, I_BGU, I_WDN, I_BDN,
       I_HYWIN, I_HYBIN, I_HYCW, I_HYCB, I_HYFW1, I_HYFB1, I_HYFW2, I_HYFB2, I_HYFW3, I_HYFREQ, I_HYFBIAS, I_HYWOUT, I_HYBOUT,
       I_S5ARE, I_S5AIM, I_S5LS, I_S5BRE, I_S5BIM, I_S5CRE, I_S5CIM, I_S5D, I_S5W1, I_S5B1, I_S5W2, I_S5B2,
       I_MLWUP, I_MLCW, I_MLCB, I_MLWQ, I_MLWK, I_MLWV, I_MLIGW, I_MLIGB, I_MLFGW, I_MLFGB, I_MLONG, I_MLSKIP, I_MLWDN, I_FNG, N_IN };

constexpr size_t al256(size_t x) { return (x + 255) & ~(size_t)255; }
constexpr size_t WS_CTL = 0;
constexpr size_t CTL_BYTES = 65536;
constexpr size_t CTL_CNT = 16384;
constexpr size_t WS_MOD = WS_CTL + CTL_BYTES;
constexpr size_t WS_X = al256(WS_MOD + (size_t)DEPTH * NMODR * 6 * DM * 4);
constexpr size_t WS_HB = al256(WS_X + (size_t)NTOK * DM * 4);
constexpr size_t WS_WHYIN = al256(WS_HB + (size_t)NTOK * DM * 2);
constexpr size_t WS_WHYOUT = al256(WS_WHYIN + (size_t)2 * 3 * DM * DM * 2);
constexpr size_t WS_WS5 = al256(WS_WHYOUT + (size_t)2 * DM * DM * 2);
constexpr size_t WS_WMLUP = al256(WS_WS5 + (size_t)2 * DM * DM * 2);
constexpr size_t WS_WMLDN = al256(WS_WMLUP + (size_t)2 * DI * DM * 2);
constexpr size_t WS_WGU = al256(WS_WMLDN + (size_t)DM * DI * 2);
constexpr size_t WS_WDN = al256(WS_WGU + (size_t)DEPTH * NE * 2 * FF * DM * 2);
constexpr size_t WS_GW = al256(WS_WDN + (size_t)DEPTH * NE * DM * FF * 2);
constexpr size_t WS_RWT = al256(WS_GW + (size_t)16 * 3 * DI * 2);
constexpr size_t WS_FRAWT = al256(WS_RWT + (size_t)DEPTH * NE * DM * 4);
constexpr size_t WS_FPART = al256(WS_FRAWT + (size_t)3 * 2 * DM * SEQ * 4);
constexpr size_t WS_FR = al256(WS_FPART + (size_t)3 * (SEQ / 8) * 2 * DM * 4);
constexpr size_t WS_TOPE = al256(WS_FR + (size_t)3 * DM * 2 * SEQ * 2);
constexpr size_t WS_TOPG = al256(WS_TOPE + (size_t)NTOK * 4 * 4);
constexpr size_t WS_TOPR = al256(WS_TOPG + (size_t)NTOK * 4 * 4);
constexpr size_t WS_PSLOT = al256(WS_TOPR + (size_t)NTOK * 4 * 4);
constexpr size_t WS_STOK = al256(WS_PSLOT + (size_t)NTOK * 4 * 4);
constexpr size_t WS_SGATE = al256(WS_STOK + (size_t)NSLOT * 4);
constexpr size_t WS_ACT = al256(WS_SGATE + (size_t)NSLOT * 4);
constexpr size_t WS_PO = al256(WS_ACT + (size_t)NSLOT * FF * 2);
constexpr size_t WS_MIX = al256(WS_PO + (size_t)NSLOT * DM * 2);
constexpr size_t MX_U = 0;
constexpr size_t MX_X0 = al256(MX_U + (size_t)NTOK * 3 * DM * 2);
constexpr size_t MX_ZT = al256(MX_X0 + (size_t)NTOK * DM * 2);
constexpr size_t MX_YT = al256(MX_ZT + (size_t)NTOK * DM * 2);
constexpr size_t MX_HY_END = al256(MX_YT + (size_t)NTOK * DM * 2);
constexpr size_t MX_HF = 0;
constexpr size_t MX_YS = al256(MX_HF + (size_t)NTOK * DM * 4);
constexpr size_t MX_S5_END = al256(MX_YS + (size_t)2 * NTOK * DM * 4);
constexpr size_t MX_XMZ = 0;
constexpr size_t MX_Q = al256(MX_XMZ + (size_t)NTOK * 2 * DI * 2);
constexpr size_t MX_K = al256(MX_Q + (size_t)NTOK * DI * 2);
constexpr size_t MX_V = al256(MX_K + (size_t)NTOK * DI * 2);
constexpr size_t MX_XC = al256(MX_V + (size_t)NTOK * DI * 2);
constexpr size_t MX_KT = al256(MX_XC + (size_t)NTOK * DI * 2);
constexpr size_t MX_VT = al256(MX_KT + (size_t)NTOK * DI * 2);
constexpr size_t MX_GATE = al256(MX_VT + (size_t)NTOK * DI * 2);
constexpr size_t MX_NUM = al256(MX_GATE + (size_t)NTOK * 16 * 4);
constexpr size_t MX_DEN = al256(MX_NUM + (size_t)2 * NLAT * DI * 2);
constexpr size_t MX_HB2 = al256(MX_DEN + (size_t)2 * NLAT * NH * 4);
constexpr size_t MX_GQ = al256(MX_HB2 + (size_t)NLAT * DI * 2);
constexpr size_t MX_GWT = al256(MX_GQ + (size_t)2 * NH * NTOK * 4);
constexpr size_t MX_DEC = al256(MX_GWT + (size_t)2 * NH * NTOK * 4);
constexpr size_t MX_P = al256(MX_DEC + (size_t)2 * BATCH * NH * ((CTX_LEN + SEQ) / 64) * 4);
constexpr size_t MX_KTW = al256(MX_P + (size_t)2 * BATCH * NH * (SEQ / 64) * 4096 * 2);
constexpr size_t MX_RP = al256(MX_KTW + (size_t)2 * NTOK * DI * 2);
constexpr size_t MX_KS = al256(MX_RP + (size_t)2 * NLAT * NH * 4);
constexpr size_t MX_ML_END = al256(MX_KS + (size_t)2 * BATCH * NH * ((CTX_LEN + SEQ) / 64) * DH * 4);
constexpr size_t mx3(size_t a, size_t b, size_t c) { return a > b ? (a > c ? a : c) : (b > c ? b : c); }
constexpr size_t WS_END = WS_MIX + mx3(MX_HY_END, MX_S5_END, MX_ML_END);

DEV float bf2f(bf16_t h) { return __builtin_bit_cast(float, (unsigned)h << 16); }
#ifdef CPU_EMU
DEV bf16_t f2bf(float f) { unsigned u = __builtin_bit_cast(unsigned, f); u += 0x7FFFu + ((u >> 16) & 1u); return (bf16_t)(u >> 16); }
DEV unsigned pack2(float a, float b) { return (unsigned)f2bf(a) | ((unsigned)f2bf(b) << 16); }
#else
typedef __bf16 bf16v2_t __attribute__((ext_vector_type(2)));
DEV unsigned pack2(float a, float b) { const f32x2 v = {a, b}; return __builtin_bit_cast(unsigned, __builtin_convertvector(v, bf16v2_t)); }
DEV bf16_t f2bf(float f) { return __builtin_bit_cast(bf16_t, (__bf16)f); }
#endif
#ifdef CPU_EMU
DEV float fexp2_(float x) { return exp2f(x); }
DEV float frcp_(float x) { return 1.f / x; }
#else
DEV float fexp2_(float x) { return __builtin_amdgcn_exp2f(x); }
DEV float frcp_(float x) { return __builtin_amdgcn_rcpf(x); }
#endif
#ifdef CPU_EMU
DEV float fsin_(float x) { return sinf(x); }
DEV float fcos_(float x) { return cosf(x); }
#else
DEV float fsin_(float x) { const float t = x * 0.15915494309189535f; return __builtin_amdgcn_sinf(t - floorf(t)); }
DEV float fcos_(float x) { const float t = x * 0.15915494309189535f; return __builtin_amdgcn_cosf(t - floorf(t)); }
#endif
DEV float sigmoidf_(float x) { return frcp_(1.f + fexp2_(-1.4426950408889634f * x)); }
DEV float siluf_(float x) { return x * sigmoidf_(x); }
DEV float wave_sum(float v) { for (int m = 32; m >= 1; m >>= 1) v += __shfl_xor(v, m); return v; }
DEV f32x4 mfma16(bf16x8 a, bf16x8 b, f32x4 c) {
#ifdef CPU_EMU
    return emu_mfma_16x16x32_bf16(a, b, c);
#else
    return __builtin_amdgcn_mfma_f32_16x16x32_bf16(a, b, c, 0, 0, 0);
#endif
}
#ifdef CPU_EMU
#define UNIFORM(x) (x)
#else
#define UNIFORM(x) __builtin_amdgcn_readfirstlane(x)
#endif
#ifdef CPU_EMU
#define SCHED_FENCE() do { } while (0)
#else
#define SCHED_FENCE() __builtin_amdgcn_sched_barrier(0)
#endif
DEV bf16x8 ld8(const void* p) { return *(const bf16x8*)p; }
#ifdef CPU_EMU
typedef const char* rsrc_t;
DEV rsrc_t mk_rsrc(const void* p) { return (const char*)p; }
DEV bf16x8 bld(rsrc_t r, unsigned voff, unsigned soff) { return *(const bf16x8*)(r + voff + soff); }
#else
typedef __amdgpu_buffer_rsrc_t rsrc_t;
DEV rsrc_t mk_rsrc(const void* p) { return __builtin_amdgcn_make_buffer_rsrc((void*)p, 0, 0xFFFFFFFF, 0x00020000); }
DEV bf16x8 bld(rsrc_t r, unsigned voff, unsigned soff) { return __builtin_bit_cast(bf16x8, __builtin_amdgcn_raw_buffer_load_b128(r, voff, soff, 0)); }
#endif
DEV bf16x8 ldo(const void* ubase, unsigned lane_off) { return *(const bf16x8*)((const char*)ubase + lane_off); }
DEV bf16x8 zero8() { bf16x8 z = {0, 0, 0, 0, 0, 0, 0, 0}; return z; }

struct Params {
    const float* in[N_IN];
    float* out;
    unsigned char* ws;
    int ph_lo, ph_hi;
};
struct Ctx {
    const Params* p; unsigned char* ws; unsigned char* lds; int tid, lane, wave, nblk, blk; float pscale; bool x_from_inputs;
};
DEV const float* mod_ptr(const Ctx& c, int layer, int mrow, int which) { return (const float*)(c.ws + WS_MOD) + (((size_t)layer * NMODR + mrow) * 6 + which) * DM; }
DEV int mod_row_of(int row) { return row < NCTX ? 0 : 1 + (row - NCTX) / SEQ; }

#ifndef CPU_EMU
#define LAS __attribute__((address_space(3)))
#define XB_TMO      128
#define XB_XCNT(j)  (256  + 64 * (j))
#define XB_XSUB(j)  (1280 + 64 * (j))
#define XB_XGEN(j)  (2304 + 64 * (j))
#define XB_TOP      3328
#define XB_TOPGEN   3392
#define XCD_BAR_WORDS 3456
#define XB_SPIN_CAP (1u << 22)
__device__ __forceinline__ unsigned xb_ld(unsigned* p)              { return __hip_atomic_load(p, __ATOMIC_RELAXED, __HIP_MEMORY_SCOPE_AGENT); }
__device__ __forceinline__ unsigned xb_add(unsigned* p, unsigned v) { return __hip_atomic_fetch_add(p, v, __ATOMIC_RELAXED, __HIP_MEMORY_SCOPE_AGENT); }
__device__ __forceinline__ unsigned xb_xcc_id() { return (unsigned)__builtin_amdgcn_s_getreg((3 << 11) | 20) & 0xFu; }
#define XB_SPIN(cond, bar) do { unsigned _sp = 0; while (cond) { __builtin_amdgcn_s_sleep(1); \
    if ((++_sp & 255u) == 0u) { if (xb_ld(&(bar)[XB_TMO])) break; if (_sp > XB_SPIN_CAP) { atomicAdd(&(bar)[XB_TMO], 1u); break; } } } } while (0)
struct XcdBarrier { unsigned* bar; unsigned x; volatile LAS unsigned* st; };
__device__ __forceinline__ XcdBarrier xcd_barrier_post(unsigned* bar, volatile LAS unsigned* st) {
    XcdBarrier b; b.bar = bar; b.x = xb_xcc_id(); b.st = st;
    if (threadIdx.x == 0) (void)xb_add(&bar[XB_XCNT(b.x)], 1u);
    return b;
}
__device__ __forceinline__ void xcd_barrier_complete(unsigned* bar, unsigned x, unsigned& nloc, unsigned& nx) {
    const unsigned G = gridDim.x * gridDim.y * gridDim.z;
    unsigned sum, cnt, mine, sp = 0u;
    for (;;) {
        sum = 0u; cnt = 0u; mine = 0u;
#pragma unroll
        for (unsigned j = 0; j < 16; ++j) { const unsigned c = xb_ld(&bar[XB_XCNT(j)]); sum += c; cnt += (c > 0u) ? 1u : 0u; mine = (j == x) ? c : mine; }
        if (sum == G) break;
        __builtin_amdgcn_s_sleep(1);
        if ((++sp & 255u) == 0u) { if (xb_ld(&bar[XB_TMO])) break; if (sp > XB_SPIN_CAP) { atomicAdd(&bar[XB_TMO], 1u); break; } }
    }
    nloc = mine > 0u ? mine : 1u; nx = cnt > 0u ? cnt : 1u;
}
__device__ __forceinline__ void xcd_barrier(const XcdBarrier& b) {
    asm volatile("s_waitcnt vmcnt(0)" ::: "memory");
    __syncthreads();
    if (threadIdx.x == 0) {
        unsigned* bar = b.bar;
        __builtin_amdgcn_s_waitcnt(0);
        unsigned nloc = b.st[0], nx = b.st[1];
        if (nloc == 0u) { xcd_barrier_complete(bar, b.x, nloc, nx); b.st[0] = nloc; b.st[1] = nx; }
        const unsigned old = xb_add(&bar[XB_XSUB(b.x)], 1u);
        const unsigned gen = old / nloc;
        if (old + 1u == (gen + 1u) * nloc) {
            __builtin_amdgcn_fence(__ATOMIC_RELEASE, "agent");
            asm volatile("s_waitcnt vmcnt(0)" ::: "memory");
            const unsigned og = xb_add(&bar[XB_TOP], 1u);
            const unsigned tg = og / nx;
            if (og + 1u == (tg + 1u) * nx) xb_add(&bar[XB_TOPGEN], 1u);
            else XB_SPIN(xb_ld(&bar[XB_TOPGEN]) == tg, bar);
            __builtin_amdgcn_fence(__ATOMIC_ACQUIRE, "agent");
            xb_add(&bar[XB_XGEN(b.x)], 1u);
            asm volatile("s_waitcnt vmcnt(0)" ::: "memory");
        } else {
            XB_SPIN(xb_ld(&bar[XB_XGEN(b.x)]) == gen, bar);
            __builtin_amdgcn_fence(__ATOMIC_ACQUIRE, "agent");
            asm volatile("s_waitcnt vmcnt(0)" ::: "memory");
        }
    }
    __syncthreads();
}
#endif

constexpr int G_BM = 256, G_BK = 64, G_HALF = 128, G_HTB = G_HALF * G_BK * 2, G_STAGE_BYTES = 8 * G_HTB;
constexpr int LDS_TAB = G_STAGE_BYTES;
constexpr int LDS_BYTES = 152 * 1024;
#ifdef CPU_EMU
#define LAS
DEV void glds16(const void* g, void* l) { memcpy((char*)l + (threadIdx.x & 63) * 16, g, 16); }
#define G_BAR() __syncthreads()
#define G_WAIT_V(n) do { } while (0)
#define G_WAIT_L(n) do { } while (0)
#define G_SETPRIO(x) do { } while (0)
#else
DEV void glds16(const void* g, void* l) { __builtin_amdgcn_global_load_lds((const unsigned*)g, (LAS unsigned*)l, 16, 0, 0); }
#define G_BAR() __builtin_amdgcn_s_barrier()
#define G_WAIT_V(n) asm volatile("s_waitcnt vmcnt(" #n ")" ::: "memory")
#define G_WAIT_L(n) asm volatile("s_waitcnt lgkmcnt(" #n ")" ::: "memory")
#define G_SETPRIO(x) __builtin_amdgcn_s_setprio(x)
#endif
DEV int g_lds_byte(int r, int c) { const int st = (r >> 4) * 2 + (c >> 5), rr = r & 15, cc = c & 31, ob = rr * 64 + cc * 2; return st * 1024 + (ob ^ (((ob >> 9) & 1) << 5)); }
DEV void g_stage_rc(int b, int& R, int& C) { const int st = b / 1024, sb = b % 1024, swz = sb ^ (((sb >> 9) & 1) << 5); R = (st >> 1) * 16 + swz / 64; C = (st & 1) * 32 + (swz % 64) / 2; }
DEV int g_perm32(int rho) { const int n = rho >> 4, i = rho & 15; return 8 * (i >> 2) + 4 * n + (i & 3); }
struct GUnit { unsigned aoff[2][2]; const char* bptr; int m0, n0, aux; };

template <class Sched, class Epi>
DEV void gemm_phase(unsigned char* lds, const bf16_t* Abase, int K, const Sched& S, const Epi& E) {
    const int tid = threadIdx.x, wid = UNIFORM(tid >> 6), lane = tid & 63, wr = wid >> 2, wc = wid & 3, fr = lane & 15, fq = lane >> 4;
    const int nt = K / G_BK;
    unsigned voffB[2];
#pragma unroll
    for (int i = 0; i < 2; ++i) { int R, C; g_stage_rc(tid * 16 + i * 8192, R, C); const int Rb = Epi::PERM ? ((R & ~31) + g_perm32(R & 31)) : R; voffB[i] = (unsigned)(Rb * K + C) * 2u; }
    const size_t kstep = (size_t)(G_BK * 2);
    const size_t hstep = (size_t)G_HALF * K * 2;
    const unsigned ldsw = (unsigned)wid * 1024u;
    const int aoff_l = g_lds_byte(wr * 64 + fr, fq * 8), boff_l = g_lds_byte(wc * 32 + fr, fq * 8);
    const char* Ab = (const char*)Abase;
#define G_SA(b, h) (((b) * 2 + (h)) * G_HTB)
#define G_SB(b, h) ((4 + (b) * 2 + (h)) * G_HTB)
#define G_STAGE_A(bufoff, koff, ao) do { _Pragma("unroll") for (int _i = 0; _i < 2; ++_i) glds16(Ab + (koff) + (ao)[_i], lds + (bufoff) + ldsw + _i * 8192); } while (0)
#define G_STAGE_B(bufoff, gbase) do { _Pragma("unroll") for (int _i = 0; _i < 2; ++_i) glds16((gbase) + voffB[_i], lds + (bufoff) + ldsw + _i * 8192); } while (0)
#define G_LDA(dst, b, h) do { _Pragma("unroll") for (int m = 0; m < 4; ++m) _Pragma("unroll") for (int k = 0; k < 2; ++k) dst[m][k] = *(const bf16x8*)(lds + G_SA(b, h) + aoff_l + m * 2048 + k * 1024); } while (0)
#define G_LDB(dst, b, h) do { _Pragma("unroll") for (int n = 0; n < 2; ++n) _Pragma("unroll") for (int k = 0; k < 2; ++k) dst[n][k] = *(const bf16x8*)(lds + G_SB(b, h) + boff_l + n * 2048 + k * 1024); } while (0)
#define G_MMA(ai, bj, At_, Bt_) do { G_SETPRIO(1); _Pragma("unroll") for (int m = 0; m < 4; ++m) _Pragma("unroll") for (int n = 0; n < 2; ++n) _Pragma("unroll") for (int k = 0; k < 2; ++k) \
        acc[ai][bj][m][n] = mfma16(Bt_[n][k], At_[m][k], acc[ai][bj][m][n]); G_SETPRIO(0); } while (0)
    GUnit cur, nxt; int ui = 0;
    if (!S.next(0, cur)) return;
    f32x4 acc[2][2][4][2];
#pragma unroll
    for (int a = 0; a < 2; ++a)
#pragma unroll
        for (int b = 0; b < 2; ++b)
#pragma unroll
            for (int m = 0; m < 4; ++m)
#pragma unroll
                for (int n = 0; n < 2; ++n) acc[a][b][m][n] = (f32x4){0.f, 0.f, 0.f, 0.f};
    bf16x8 At[4][2], B0[2][2], B1[2][2];
    const char* cB = cur.bptr;
    G_STAGE_B(G_SB(0, 0), cB); G_STAGE_B(G_SB(0, 1), cB + hstep); G_STAGE_A(G_SA(0, 0), 0, cur.aoff[0]); G_STAGE_A(G_SA(0, 1), 0, cur.aoff[1]);
    if (wr == 1) G_BAR();
    G_WAIT_V(2); G_BAR();
    G_STAGE_B(G_SB(1, 0), cB + kstep); G_STAGE_A(G_SA(1, 0), kstep, cur.aoff[0]); G_STAGE_B(G_SB(1, 1), cB + hstep + kstep);
    G_WAIT_V(6); G_BAR();
    for (;;) {
        const bool has_next = S.next(ui + 1, nxt);
        if (!has_next) nxt = cur;
        const char* nB = nxt.bptr;
        for (int t = 0; t < nt; t += 2) {
            const bool last = (t == nt - 2);
            const size_t k1 = (size_t)(t + 1) * kstep;
            const size_t k2 = last ? 0 : (size_t)(t + 2) * kstep, k3 = k2 + kstep;
            const char* b2 = last ? nB : cB + k2; const char* b3 = b2 + kstep;
            unsigned a2o0[2], a2o1[2];
#pragma unroll
            for (int i = 0; i < 2; ++i) { a2o0[i] = last ? nxt.aoff[0][i] : cur.aoff[0][i]; a2o1[i] = last ? nxt.aoff[1][i] : cur.aoff[1][i]; }
            G_LDB(B0, 0, 0); G_LDB(B1, 0, 1); SCHED_FENCE(); G_LDA(At, 0, 0); G_STAGE_A(G_SA(1, 1), k1, cur.aoff[1]);
            G_WAIT_V(8); G_WAIT_L(0); G_BAR(); G_MMA(0, 0, At, B0); G_MMA(0, 1, At, B1); G_BAR(); SCHED_FENCE();
            G_LDA(At, 0, 1); G_STAGE_B(G_SB(0, 0), b2); G_STAGE_B(G_SB(0, 1), b2 + hstep); G_STAGE_A(G_SA(0, 0), k2, a2o0);
            G_WAIT_V(8); G_WAIT_L(0); G_BAR(); G_MMA(1, 0, At, B0); G_MMA(1, 1, At, B1); G_BAR(); SCHED_FENCE();
            G_LDB(B0, 1, 0); G_LDB(B1, 1, 1); SCHED_FENCE(); G_LDA(At, 1, 0); G_STAGE_A(G_SA(0, 1), k2, a2o1);
            G_WAIT_V(8); G_WAIT_L(0); G_BAR(); G_MMA(0, 0, At, B0); G_MMA(0, 1, At, B1); G_BAR(); SCHED_FENCE();
            G_LDA(At, 1, 1); G_STAGE_B(G_SB(1, 0), b3); G_STAGE_B(G_SB(1, 1), b3 + hstep); G_STAGE_A(G_SA(1, 0), k3, a2o0);
            G_WAIT_V(8); G_WAIT_L(0); G_BAR(); G_MMA(1, 0, At, B0); G_MMA(1, 1, At, B1); G_BAR(); SCHED_FENCE();
        }
        if (wr == 0) G_BAR();
        E(acc, cur, wr, wc, fr, fq);
        if (!has_next) break;
#pragma unroll
        for (int a = 0; a < 2; ++a)
#pragma unroll
            for (int b = 0; b < 2; ++b)
#pragma unroll
                for (int m = 0; m < 4; ++m)
#pragma unroll
                    for (int n = 0; n < 2; ++n) acc[a][b][m][n] = (f32x4){0.f, 0.f, 0.f, 0.f};
        cur = nxt; cB = nB; ++ui;
        if (wr == 1) G_BAR();
    }
    G_WAIT_V(0);
    G_BAR();
#undef G_SA
#undef G_SB
#undef G_STAGE_A
#undef G_STAGE_B
#undef G_LDA
#undef G_LDB
#undef G_MMA
}
DEV void g_fill_aoff(GUnit& u, int K, int tid, const int* rowidx  , int m_first) {
#pragma unroll
    for (int i = 0; i < 2; ++i) { int R, C; g_stage_rc(tid * 16 + i * 8192, R, C);
#pragma unroll
        for (int h = 0; h < 2; ++h) { int row; if (rowidx) { row = rowidx[h * G_HALF + R]; row = row < 0 ? 0 : row; } else row = m_first + h * G_HALF + R;
            u.aoff[h][i] = (unsigned)(((size_t)row * K + C) * 2); } }
}
DEV bool xcd_deal(int i, int blk, int nblk, int nM, int nN, int& mt, int& pn) {
    const int XC = (nblk % 8 == 0) ? 8 : 1, x = blk % XC, l = blk / XC, W = nblk / XC;
    const int t0 = (int)(((long)x * nM) / XC), t1 = (int)(((long)(x + 1) * nM) / XC);
    const int id = l + i * W; if (id >= (t1 - t0) * nN) return false;
    mt = t0 + id / nN; pn = id % nN; return true;
}
struct DenseSched {
    int row_lo, nM, nN, K, blk, nblk, tid; const bf16_t* Bt;
    DEV bool next(int i, GUnit& u) const {
        int pm, pn; if (!xcd_deal(i, blk, nblk, nM, nN, pm, pn)) return false;
        u.m0 = row_lo + pm * G_BM; u.n0 = pn * G_BM; u.aux = 0; u.bptr = (const char*)(Bt + (size_t)u.n0 * K);
        g_fill_aoff(u, K, tid, nullptr, u.m0); return true; }
};
template <class Epi>
DEV void gemm_dense_phase(const Ctx& c, const bf16_t* A, int row_lo, int nrows, const bf16_t* Bt, int N, int K, const Epi& E) {
    DenseSched S{row_lo, nrows / G_BM, N / G_BM, K, c.blk, c.nblk, c.tid, Bt};
    gemm_phase(c.lds, A, K, S, E);
}

#define EPI_LOOP_ROWS(ai, m) _Pragma("unroll") for (int ai = 0; ai < 2; ++ai) _Pragma("unroll") for (int m = 0; m < 4; ++m)
#define EPI_LOOP_COLS(bj, n) _Pragma("unroll") for (int bj = 0; bj < 2; ++bj) _Pragma("unroll") for (int n = 0; n < 2; ++n)
struct EpiBf16 {
    static constexpr bool PERM = true;
    bf16_t* O; int ld; const float* bias;
    DEV void operator()(const f32x4 (&acc)[2][2][4][2], const GUnit& u, int wr, int wc, int fr, int fq) const {
        const int row0 = u.m0 + wr * 64 + fr, col0 = u.n0 + wc * 32 + 8 * fq;
        f32x4 bv[2][2];
        EPI_LOOP_COLS(bj, n) bv[bj][n] = bias ? *(const f32x4*)(bias + col0 + bj * G_HALF + 4 * n) : (f32x4){0.f, 0.f, 0.f, 0.f};
        EPI_LOOP_ROWS(ai, m) { bf16_t* rp = O + (size_t)(row0 + ai * G_HALF + m * 16) * ld + col0;
#pragma unroll
            for (int bj = 0; bj < 2; ++bj) { const f32x4 v0 = acc[ai][bj][m][0] + bv[bj][0], v1 = acc[ai][bj][m][1] + bv[bj][1];
                u32x4 w; w[0] = pack2(v0[0], v0[1]); w[1] = pack2(v0[2], v0[3]); w[2] = pack2(v1[0], v1[1]); w[3] = pack2(v1[2], v1[3]); *(u32x4*)(rp + bj * G_HALF) = w; } }
    }
};
struct EpiResid {
    static constexpr bool PERM = false;
    float* X; const float* bias; const float* modbase; bool perm; float ps; const float* const* ins;
    DEV const float* src_row(int row) const { if (!ins) return X + (size_t)row * DM; return row < NCTX ? ins[I_CTX] + (size_t)row * DM : ins[I_X] + (size_t)(row - NCTX) * DM; }
    DEV int orow(int row) const { if (!perm) return row; const int r = row - NCTX, b = r / SEQ, pp = r % SEQ; return NCTX + b * SEQ + (pp % ROWS_G) * GRID_W + pp / ROWS_G; }
    DEV void operator()(const f32x4 (&acc)[2][2][4][2], const GUnit& u, int wr, int wc, int fr, int fq) const {
        const int row0 = u.m0 + wr * 64 + fr, col0 = u.n0 + wc * 32 + 4 * fq;
        f32x4 bv[2][2];
        EPI_LOOP_COLS(bj, n) bv[bj][n] = bias ? *(const f32x4*)(bias + col0 + bj * G_HALF + n * 16) : (f32x4){0.f, 0.f, 0.f, 0.f};
        f32x4 xv[2][2], xn[2][2];
        { const float* xp = src_row(orow(row0)) + col0; EPI_LOOP_COLS(bj, n) xv[bj][n] = *(const f32x4*)(xp + bj * G_HALF + n * 16); }
#pragma unroll
        for (int ai = 0; ai < 2; ++ai) {
            f32x4 mv[2][2];
            EPI_LOOP_COLS(bj, n) mv[bj][n] = *(const f32x4*)(modbase + (size_t)mod_row_of(u.m0 + ai * G_HALF) * 6 * DM + 2 * DM + col0 + bj * G_HALF + n * 16) * ps;
#pragma unroll
            for (int m = 0; m < 4; ++m) {
                const int g = ai * 4 + m;
                if (g < 7) { const int gn = g + 1; const float* xq = src_row(orow(row0 + (gn >> 2) * G_HALF + (gn & 3) * 16)) + col0; EPI_LOOP_COLS(bj, n) xn[bj][n] = *(const f32x4*)(xq + bj * G_HALF + n * 16); }
                float* xp = X + (size_t)orow(row0 + ai * G_HALF + m * 16) * DM + col0;
                EPI_LOOP_COLS(bj, n) *(f32x4*)(xp + bj * G_HALF + n * 16) = xv[bj][n] + mv[bj][n] * (acc[ai][bj][m][n] + bv[bj][n]);
                EPI_LOOP_COLS(bj, n) xv[bj][n] = xn[bj][n];
            }
            SCHED_FENCE();
        }
    }
};
struct EpiGlu {
    static constexpr bool PERM = false;
    float* X; const float* b1; const float* b2; const float* modbase; float ps;
    DEV void operator()(const f32x4 (&acc)[2][2][4][2], const GUnit& u, int wr, int wc, int fr, int fq) const {
        const int row0 = u.m0 + wr * 64 + fr, col0 = (u.n0 + wc * 32 + 4 * fq) / 2;
        f32x2 v1[2][2], v2[2][2], mv[2][2][2];
        EPI_LOOP_COLS(bj, n) { const int co = (bj * G_HALF + n * 16) / 2; v1[bj][n] = *(const f32x2*)(b1 + col0 + co); v2[bj][n] = *(const f32x2*)(b2 + col0 + co);
#pragma unroll
            for (int ai = 0; ai < 2; ++ai) mv[ai][bj][n] = *(const f32x2*)(modbase + (size_t)mod_row_of(u.m0 + ai * G_HALF) * 6 * DM + 2 * DM + col0 + co); }
        f32x2 xv[2][2], xn[2][2];
        { float* xp = X + (size_t)row0 * DM + col0; EPI_LOOP_COLS(bj, n) xv[bj][n] = *(const f32x2*)(xp + (bj * G_HALF + n * 16) / 2); }
        EPI_LOOP_ROWS(ai, m) {
            const int g = ai * 4 + m;
            if (g < 7) { const int gn = g + 1; float* xq = X + (size_t)(row0 + (gn >> 2) * G_HALF + (gn & 3) * 16) * DM + col0; EPI_LOOP_COLS(bj, n) xn[bj][n] = *(const f32x2*)(xq + (bj * G_HALF + n * 16) / 2); }
            float* xp = X + (size_t)(row0 + ai * G_HALF + m * 16) * DM + col0;
            EPI_LOOP_COLS(bj, n) { const f32x4 v = acc[ai][bj][m][n]; f32x2 o = xv[bj][n];
                o[0] += ps * mv[ai][bj][n][0] * (v[0] + v1[bj][n][0]) * sigmoidf_(v[1] + v2[bj][n][0]); o[1] += ps * mv[ai][bj][n][1] * (v[2] + v1[bj][n][1]) * sigmoidf_(v[3] + v2[bj][n][1]);
                *(f32x2*)(xp + (bj * G_HALF + n * 16) / 2) = o; }
            EPI_LOOP_COLS(bj, n) xv[bj][n] = xn[bj][n];
        }
    }
};
struct EpiSwiglu {
    static constexpr bool PERM = true;
    bf16_t* O; const float* bgu_all; float ps;
    DEV void operator()(const f32x4 (&acc)[2][2][4][2], const GUnit& u, int wr, int wc, int fr, int fq) const {
        const float* bgu = bgu_all + (size_t)u.aux * 2 * FF;
        const int row0 = u.m0 + wr * 64 + fr, c0 = u.n0 + wc * 32 + 8 * fq;
        f32x4 bv[2][2];
        EPI_LOOP_COLS(bj, n) bv[bj][n] = *(const f32x4*)(bgu + c0 + bj * G_HALF + 4 * n);
        EPI_LOOP_ROWS(ai, m) { bf16_t* rp = O + (size_t)(row0 + ai * G_HALF + m * 16) * FF + c0 / 2;
#pragma unroll
            for (int bj = 0; bj < 2; ++bj) { float o[4];
#pragma unroll
                for (int n = 0; n < 2; ++n) { const f32x4 v = acc[ai][bj][m][n] + bv[bj][n];
                    const float g0 = fminf(v[0], 7.f), u0 = fminf(fmaxf(v[1], -7.f), 7.f), g1 = fminf(v[2], 7.f), u1 = fminf(fmaxf(v[3], -7.f), 7.f);
                    o[2 * n] = (u0 + 1.f) * g0 * sigmoidf_(1.702f * g0); o[2 * n + 1] = (u1 + 1.f) * g1 * sigmoidf_(1.702f * g1); }
                u32x2 w; w[0] = pack2(o[0], o[1]); w[1] = pack2(o[2], o[3]); *(u32x2*)(rp + bj * (G_HALF / 2)) = w; } }
    }
};
struct EpiMoeDown {
    static constexpr bool PERM = true;
    bf16_t* O; const float* bd_all; const float* sgate; float ps;
    DEV void operator()(const f32x4 (&acc)[2][2][4][2], const GUnit& u, int wr, int wc, int fr, int fq) const {
        const float* bd = bd_all + (size_t)u.aux * DM;
        const int row0 = u.m0 + wr * 64 + fr, col0 = u.n0 + wc * 32 + 8 * fq;
        f32x4 bv[2][2]; float gt[2][4];
        EPI_LOOP_COLS(bj, n) bv[bj][n] = *(const f32x4*)(bd + col0 + bj * G_HALF + 4 * n);
        EPI_LOOP_ROWS(ai, m) gt[ai][m] = sgate[row0 + ai * G_HALF + m * 16];
        EPI_LOOP_ROWS(ai, m) { const int slot = row0 + ai * G_HALF + m * 16; const float g = gt[ai][m]; bf16_t* rp = O + (size_t)slot * DM + col0;
#pragma unroll
            for (int bj = 0; bj < 2; ++bj) { const f32x4 v0 = (acc[ai][bj][m][0] + bv[bj][0]) * g, v1 = (acc[ai][bj][m][1] + bv[bj][1]) * g;
                u32x4 w; w[0] = pack2(v0[0], v0[1]); w[1] = pack2(v0[2], v0[3]); w[2] = pack2(v1[0], v1[1]); w[3] = pack2(v1[2], v1[3]); *(u32x4*)(rp + bj * G_HALF) = w; } }
    }
};

DEV void grid_copy_f4(const Ctx& c, const float* src, float* dst, size_t n) {
    const size_t n4 = n / 4;
    for (size_t i = (size_t)c.blk * NT + c.tid; i < n4; i += (size_t)c.nblk * NT) ((f32x4*)dst)[i] = ((const f32x4*)src)[i];
}
constexpr int MODS_KS = 8, MODS_KL = DM / MODS_KS;
DEV void mods_phase(const Ctx& c) {
    float* sc = (float*)c.lds;
    const float* cc = c.p->in[I_C]; const float* cx = c.p->in[I_CCTX];
    float* PART = (float*)(c.ws + WS_MIX);
    const int ncb = 6 * DM / NT, units = DEPTH * ncb * MODS_KS;
    for (int u = c.blk; u < units; u += c.nblk) {
        const int ks = u % MODS_KS, l = (u / MODS_KS) / ncb, col = ((u / MODS_KS) % ncb) * NT + c.tid, kb = ks * MODS_KL;
        __syncthreads();
        for (int i = c.tid; i < NMODR * MODS_KL; i += NT) { const int r = i / MODS_KL, k = kb + i % MODS_KL; sc[i] = siluf_(r == 0 ? cx[k] : cc[(r - 1) * DM + k]); }
        __syncthreads();
        const float* W = c.p->in[I_ADAW] + (size_t)l * DM * 6 * DM + (size_t)kb * 6 * DM + col;
        float acc[NMODR];
#pragma unroll
        for (int r = 0; r < NMODR; ++r) acc[r] = 0.f;
        for (int k0 = 0; k0 < MODS_KL; k0 += 8) { float w[8];
#pragma unroll
            for (int q = 0; q < 8; ++q) w[q] = W[(size_t)(k0 + q) * 6 * DM];
#pragma unroll
            for (int q = 0; q < 8; ++q)
#pragma unroll
                for (int r = 0; r < NMODR; ++r) acc[r] += sc[r * MODS_KL + k0 + q] * w[q]; }
#pragma unroll
        for (int r = 0; r < NMODR; ++r) PART[(((size_t)ks * DEPTH + l) * NMODR + r) * 6 * DM + col] = acc[r];
    }
    __syncthreads();
}
DEV void mods_reduce(const Ctx& c) {
    const float* PART = (const float*)(c.ws + WS_MIX); float* M = (float*)(c.ws + WS_MOD);
    const size_t n = (size_t)DEPTH * NMODR * 6 * DM;
    for (size_t i = (size_t)c.blk * NT + c.tid; i < n; i += (size_t)c.nblk * NT) { const int col = (int)(i % (6 * DM)), l = (int)(i / ((size_t)NMODR * 6 * DM));
        float a = c.p->in[I_ADAB][(size_t)l * 6 * DM + col];
#pragma unroll
        for (int ks = 0; ks < MODS_KS; ++ks) a += PART[(size_t)ks * n + i];
        M[i] = a; }
}
template <int PERM>
DEV void transpose_job(const Ctx& c, const float* src, bf16_t* dst, int K, int N, int nb, size_t dst_batch_stride, int dst_rows_total, int blk = -1, int nblk = 0) {
    if (blk < 0) { blk = c.blk; nblk = c.nblk; }
    float* tile = (float*)c.lds;
    const int tk = K / 64, tn = N / 256, per = tk * tn, units = per * nb;
    for (int u = blk; u < units; u += nblk) {
        const int b = u / per, r = u % per, k0 = (r / tn) * 64, n0 = (r % tn) * 256;
        const float* S = src + (size_t)b * K * N;
        float v[32];
#pragma unroll
        for (int i = 0; i < 32; ++i) { const int e = c.tid + NT * i, kk = e >> 8, nn = e & 255; v[i] = S[(size_t)(k0 + kk) * N + n0 + nn]; }
        __syncthreads();
#pragma unroll
        for (int i = 0; i < 32; ++i) { const int e = c.tid + NT * i, kk = e >> 8, nn = e & 255; tile[kk * 257 + nn] = v[i]; }
        __syncthreads();
        bf16_t* D = dst + (size_t)b * dst_batch_stride;
#pragma unroll
        for (int i = 0; i < 4; ++i) { const int e = c.tid + NT * i, nn = e >> 3, kc = (e & 7) * 8; const int n = n0 + nn; int np;
            if (PERM < 2) np = n; else np = 2 * n + (PERM - 2);
            u32x4 w;
#pragma unroll
            for (int q = 0; q < 4; ++q) w[q] = pack2(tile[(kc + 2 * q) * 257 + nn], tile[(kc + 2 * q + 1) * 257 + nn]);
            *(u32x4*)(D + (size_t)np * K + k0 + kc) = w; }
    }
    (void)dst_rows_total;
    __syncthreads();
}
DEV void gatew_job(const Ctx& c) {
    bf16_t* GW = (bf16_t*)(c.ws + WS_GW);
    const float sk = sqrtf((float)DH);
    for (size_t i = (size_t)c.blk * NT + c.tid; i < (size_t)16 * 3 * DI; i += (size_t)c.nblk * NT) {
        const int n = (int)(i / (3 * DI)), k = (int)(i % (3 * DI)); const int dr = n >> 3, gate = (n >> 2) & 1, head = n & 3;
        const float* W = gate ? c.p->in[I_MLFGW] : c.p->in[I_MLIGW];
        float v = W[((size_t)dr * 3 * DI + k) * NH + head];
        if (k >= DI && k < 2 * DI) v *= sk;
        GW[i] = f2bf(v);
    }
}
DEV void filter_gen_job(const Ctx& c, int job, int fj, int L) {
    float* zs = (float*)c.lds;
    float* h1 = zs + 8 * 40;
    float* h2 = h1 + 8 * 64;
    const float* w1 = c.p->in[I_HYFW1] + (size_t)fj * HY_EMB * HY_ORDER; const float* b1 = c.p->in[I_HYFB1] + fj * HY_ORDER;
    const float* w2 = c.p->in[I_HYFW2] + (size_t)fj * HY_ORDER * HY_ORDER; const float* b2 = c.p->in[I_HYFB2] + fj * HY_ORDER;
    const float* w3 = c.p->in[I_HYFW3] + (size_t)fj * HY_ORDER * 2 * DM; const float* fq = c.p->in[I_HYFREQ] + fj * HY_ORDER;
    float* FT = (float*)(c.ws + WS_FRAWT) + (size_t)job * 2 * DM * SEQ;
    float* FP = (float*)(c.ws + WS_FPART) + (size_t)job * (SEQ / 8) * 2 * DM;
    const int units = L / 8;
    const float d_lo = logf(0.3f) / 1e-2f, d_hi = logf(1.5f) / 1e-2f;
    for (int u = c.blk; u < units; u += c.nblk) {
        const int t0 = u * 8;
        __syncthreads();
        if (c.tid < 8 * HY_EMB) { const int pp = c.tid / HY_EMB, e = c.tid % HY_EMB, t = t0 + pp; float v;
            const float wt = (6.283185307179586f / (float)L) * (float)t;
            if (e == 0) v = (float)t / (float)(L - 1);
            else { const int bnd = (e - 1) & 15; const float f = 1e-4f + (float)bnd * ((15.f - 1e-4f) / 15.f); v = (e <= 16) ? cosf(f * wt) : -sinf(f * wt); }
            zs[pp * 40 + e] = v; }
        __syncthreads();
        { const int pp = c.tid >> 6, uu = c.tid & 63; float a = b1[uu]; for (int e = 0; e < HY_EMB; ++e) a += zs[pp * 40 + e] * w1[e * HY_ORDER + uu]; h1[pp * 64 + uu] = sinf(fq[uu] * a); }
        __syncthreads();
        { const int pp = c.tid >> 6, uu = c.tid & 63; float a = b2[uu]; for (int k = 0; k < HY_ORDER; ++k) a += h1[pp * 64 + k] * w2[k * HY_ORDER + uu]; h2[pp * 64 + uu] = sinf(fq[uu] * a); }
        __syncthreads();
        for (int col = c.tid; col < 2 * DM; col += NT) {
            float a[8];
#pragma unroll
            for (int pp = 0; pp < 8; ++pp) a[pp] = 0.f;
#pragma unroll 16
            for (int k = 0; k < HY_ORDER; ++k) { const float w = w3[(size_t)k * 2 * DM + col];
#pragma unroll
                for (int pp = 0; pp < 8; ++pp) a[pp] += h2[pp * 64 + k] * w; }
            const int d = col % DM; const float delta = fabsf(d_lo + (d_hi - d_lo) * (float)d / (float)(DM - 1));
            float ps = 0.f;
#pragma unroll
            for (int pp = 0; pp < 8; ++pp) { const int t = t0 + pp; const float tt = (float)t / (float)(L - 1); a[pp] *= expf(-tt * delta); if (!(col >= DM && t == 0)) ps += fabsf(a[pp]); }
            *(f32x4*)(FT + (size_t)col * SEQ + t0) = (f32x4){a[0], a[1], a[2], a[3]};
            *(f32x4*)(FT + (size_t)col * SEQ + t0 + 4) = (f32x4){a[4], a[5], a[6], a[7]};
            FP[(size_t)u * 2 * DM + col] = ps;
        }
    }
    __syncthreads();
}
DEV void filter_fin_job(const Ctx& c, int job, int fj, int L) {
    const float* FT = (const float*)(c.ws + WS_FRAWT) + (size_t)job * 2 * DM * SEQ;
    const float* FP = (const float*)(c.ws + WS_FPART) + (size_t)job * (SEQ / 8) * 2 * DM;
    bf16_t* FR = (bf16_t*)(c.ws + WS_FR) + (size_t)job * DM * 2 * SEQ;
    const float* fb = c.p->in[I_HYFBIAS] + (size_t)fj * DM;
    float* red = (float*)c.lds;
    for (int d = c.blk; d < DM; d += c.nblk) {
        float s = 0.f;
        for (int u = c.tid; u < L / 8; u += NT) s += FP[(size_t)u * 2 * DM + d] + FP[(size_t)u * 2 * DM + DM + d];
        s = wave_sum(s);
        __syncthreads();
        if (c.lane == 0) red[c.wave] = s;
        __syncthreads();
        float tot = 0.f;
#pragma unroll
        for (int w = 0; w < NT / 64; ++w) tot += red[w];
        const float inv = 1.f / tot;
        for (int u = c.tid; u < 2 * L; u += NT) {
            const int idx = (2 * L - u) % (2 * L); float v;
            if (idx < L) v = FT[(size_t)d * SEQ + idx]; else if (idx == L) v = 0.f; else v = FT[(size_t)(DM + d) * SEQ + (2 * L - idx)];
            v *= inv; if (u == 0) v += fb[d];
            FR[(size_t)d * 2 * L + u] = f2bf(v);
        }
    }
    __syncthreads();
}

constexpr int NV = DM / 256;
struct RowVals { f32x4 v[NV]; };
struct RowRaw { f32x4 x[NV]; u32x2 po[4][NV]; };
DEV const float* x_row_src(const Ctx& c, int row) { const char* xr = (const char*)((const float*)(c.ws + WS_X) + (size_t)row * DM); if (!c.x_from_inputs) return (const float*)xr;
    const long d = row < NCTX ? (long)((const char*)c.p->in[I_CTX] - (const char*)(c.ws + WS_X)) : (long)((const char*)c.p->in[I_X] - (const char*)((const float*)(c.ws + WS_X) + (size_t)NCTX * DM)); return (const float*)(xr + d); }
DEV void row_issue(const Ctx& c, RowRaw& rr, int row, bool comb, const int (&ps)[4]) {
    const float* xr = x_row_src(c, row); const bf16_t* PO = (const bf16_t*)(c.ws + WS_PO);
#pragma unroll
    for (int i = 0; i < NV; ++i) rr.x[i] = *(const f32x4*)(xr + 4 * c.lane + 256 * i);
    if (comb) {
#pragma unroll
        for (int k = 0; k < 4; ++k)
#pragma unroll
            for (int i = 0; i < NV; ++i) rr.po[k][i] = *(const u32x2*)(PO + (size_t)ps[k] * DM + 4 * c.lane + 256 * i);
    }
}
DEV void ps_issue(const Ctx& c, int (&ps)[4], int row) { const int* p = (const int*)(c.ws + WS_PSLOT) + (size_t)row * 4;
#pragma unroll
    for (int k = 0; k < 4; ++k) ps[k] = p[k]; }
DEV RowVals row_combine(const Ctx& c, const RowRaw& rr, int row, int comb_layer) {
    RowVals r;
#pragma unroll
    for (int i = 0; i < NV; ++i) r.v[i] = rr.x[i];
    if (comb_layer >= 0) {
        const float* m5 = mod_ptr(c, comb_layer, mod_row_of(row), 5); float* X = (float*)(c.ws + WS_X);
#pragma unroll
        for (int i = 0; i < NV; ++i) { f32x4 s = {0.f, 0.f, 0.f, 0.f};
#pragma unroll
            for (int k = 0; k < 4; ++k) { const u32x2 w = rr.po[k][i]; s[0] += bf2f((bf16_t)(w[0] & 0xffff)); s[1] += bf2f((bf16_t)(w[0] >> 16)); s[2] += bf2f((bf16_t)(w[1] & 0xffff)); s[3] += bf2f((bf16_t)(w[1] >> 16)); }
            const f32x4 mm = *(const f32x4*)(m5 + 4 * c.lane + 256 * i); r.v[i] = r.v[i] + mm * s; *(f32x4*)(X + (size_t)row * DM + 4 * c.lane + 256 * i) = r.v[i]; }
    }
    return r;
}
DEV void norm_mod(const Ctx& c, RowVals& r, const float* g, const float* shift, const float* scale) {
    float ss = 0.f;
#pragma unroll
    for (int i = 0; i < NV; ++i) ss += r.v[i][0] * r.v[i][0] + r.v[i][1] * r.v[i][1] + r.v[i][2] * r.v[i][2] + r.v[i][3] * r.v[i][3];
    ss = wave_sum(ss);
    const float rinv = rsqrtf(ss / (float)DM + EPS);
#pragma unroll
    for (int i = 0; i < NV; ++i) { const int o = 4 * c.lane + 256 * i; const f32x4 gg = *(const f32x4*)(g + o);
        f32x4 y = r.v[i] * rinv * gg;
        if (scale) { const f32x4 sc = *(const f32x4*)(scale + o), sh = *(const f32x4*)(shift + o); y = y * (1.f + sc) + sh; }
        r.v[i] = y; }
}
DEV void store_row_bf16(const Ctx& c, bf16_t* dst, const RowVals& r) {
#pragma unroll
    for (int i = 0; i < NV; ++i) { u32x2 w; w[0] = pack2(r.v[i][0], r.v[i][1]); w[1] = pack2(r.v[i][2], r.v[i][3]); *(u32x2*)(dst + 4 * c.lane + 256 * i) = w; }
}
template <class Body>
DEV void row_loop(const Ctx& c, int lo, int hi, int comb_layer, const Body& body) {
    const int nw = c.nblk * (NT / 64), w0 = c.blk * (NT / 64) + c.wave; const bool comb = comb_layer >= 0;
    int row = lo + w0; if (row >= hi) return;
    int ps0[4] = {0, 0, 0, 0}, ps1[4] = {0, 0, 0, 0}; RowRaw cur, nxt;
    if (comb) ps_issue(c, ps0, row);
    row_issue(c, cur, row, comb, ps0);
    if (comb && row + nw < hi) ps_issue(c, ps0, row + nw);
    for (; row < hi; row += nw) {
        const int r1 = row + nw, r2 = row + 2 * nw;
        if (r1 < hi) row_issue(c, nxt, r1, comb, ps0);
        if (comb && r2 < hi) ps_issue(c, ps1, r2);
        RowVals r = row_combine(c, cur, row, comb_layer);
        body(row, r);
        if (r1 < hi) { cur = nxt;
#pragma unroll
            for (int k = 0; k < 4; ++k) ps0[k] = ps1[k]; }
    }
}
template <int OUT>
DEV void norm1_phase(const Ctx& c, int layer, int lo, int hi, int comb_layer, const float* unused) {
    (void)unused;
    const float* g = c.p->in[I_N1G] + (size_t)layer * DM;
    row_loop(c, lo, hi, comb_layer, [&](int row, RowVals& r) {
        const int mr = mod_row_of(row);
        norm_mod(c, r, g, mod_ptr(c, layer, mr, 0), mod_ptr(c, layer, mr, 1));
        int orow = row; if (OUT == 2 && row >= NCTX) { const int rr = row - NCTX, b = rr / SEQ, t = rr % SEQ; orow = NCTX + b * SEQ + (t % GRID_W) * ROWS_G + t / GRID_W; }
        store_row_bf16(c, (bf16_t*)(c.ws + WS_HB) + (size_t)orow * DM, r); });
}
DEV void final_phase(const Ctx& c) {
    row_loop(c, NCTX, NTOK, DEPTH - 1, [&](int row, RowVals& r) {
        norm_mod(c, r, c.p->in[I_FNG], nullptr, nullptr);
        float* o = c.p->out + (size_t)(row - NCTX) * DM;
#pragma unroll
        for (int i = 0; i < NV; ++i) *(f32x4*)(o + 4 * c.lane + 256 * i) = r.v[i]; });
}
DEV void moe_route_phase(const Ctx& c, int layer, int lo, int hi) {
    float* rwT = (float*)c.lds;
    const float* rwt = (const float*)(c.ws + WS_RWT) + (size_t)layer * NE * DM; const float* rbias = c.p->in[I_RB] + (size_t)layer * NE;
    for (int i = c.tid; i < DM * NE / 4; i += NT) ((f32x4*)rwT)[i] = ((const f32x4*)rwt)[i];
    int* lcnt = (int*)(c.lds + LDS_TAB); int* lbase = lcnt + NE;
    if (c.tid < NE) lcnt[c.tid] = 0;
    int* stok = (int*)(c.ws + WS_STOK);
    for (size_t i = (size_t)c.blk * NT + c.tid; i < (size_t)NSLOT; i += (size_t)c.nblk * NT) stok[i] = -1;
    __syncthreads();
    const float* g = c.p->in[I_N2G] + (size_t)layer * DM;
    int* cnt = (int*)(c.ws + WS_CTL + CTL_CNT) + layer * NE;
    const int lane = c.lane;
    const int my_e = ((lane >> 5) & 1) * 16 + ((lane >> 4) & 1) * 8 + ((lane >> 3) & 1) * 4 + ((lane >> 2) & 1) * 2 + ((lane >> 1) & 1);
    const float my_bias = rbias[my_e];
    row_loop(c, lo, hi, -1, [&](int row, RowVals& r) {
        const int mr = mod_row_of(row);
        norm_mod(c, r, g, mod_ptr(c, layer, mr, 3), mod_ptr(c, layer, mr, 4));
        store_row_bf16(c, (bf16_t*)(c.ws + WS_HB) + (size_t)row * DM, r);
        float v[NE];
#pragma unroll
        for (int e = 0; e < NE; ++e) { float a = 0.f;
#pragma unroll
            for (int i = 0; i < NV; ++i) { const f32x4 w = *(const f32x4*)(rwT + e * DM + 4 * lane + 256 * i); a += r.v[i][0] * w[0] + r.v[i][1] * w[1] + r.v[i][2] * w[2] + r.v[i][3] * w[3]; }
            v[e] = a; if ((e & 3) == 3) SCHED_FENCE(); }
#pragma unroll
        for (int st = 0; st < 5; ++st) { const int m = 32 >> st, n2 = 16 >> st; const bool up_ = (lane & m) != 0;
#pragma unroll
            for (int i = 0; i < 16; ++i) if (i < n2) { const float send = up_ ? v[i] : v[i + n2]; const float keep = up_ ? v[i + n2] : v[i]; v[i] = keep + __shfl_xor(send, m); } }
        float mylg = v[0] + __shfl_xor(v[0], 1) + my_bias;
        int te[4]; float tv[4];
#pragma unroll
        for (int k = 0; k < 4; ++k) { float bv = mylg; int bi = my_e;
#pragma unroll
            for (int m = 32; m >= 2; m >>= 1) { const float ov = __shfl_xor(bv, m); const int oi = __shfl_xor(bi, m); const bool take = (ov > bv) || (ov == bv && oi < bi); bv = take ? ov : bv; bi = take ? oi : bi; }
            te[k] = bi; tv[k] = bv; mylg = (my_e == bi) ? -3.0e38f : mylg; }
        const float e1 = expf(tv[1] - tv[0]), e2 = expf(tv[2] - tv[0]), e3 = expf(tv[3] - tv[0]); const float inv = 1.f / (1.f + e1 + e2 + e3);
        if (lane < 4) { const int k = lane; const int e = k == 0 ? te[0] : k == 1 ? te[1] : k == 2 ? te[2] : te[3]; const float gg = (k == 0 ? 1.f : k == 1 ? e1 : k == 2 ? e2 : e3) * inv;
            const int rank = atomicAdd(&lcnt[e], 1);
            ((int*)(c.ws + WS_TOPE))[(size_t)row * 4 + k] = e; ((float*)(c.ws + WS_TOPG))[(size_t)row * 4 + k] = gg; ((int*)(c.ws + WS_TOPR))[(size_t)row * 4 + k] = rank; } });
    __syncthreads();
    if (c.tid < NE) lbase[c.tid] = atomicAdd(&cnt[c.tid], lcnt[c.tid]);
    __syncthreads();
    { const int nw = c.nblk * (NT / 64), w0 = c.blk * (NT / 64) + c.wave; const int* te = (const int*)(c.ws + WS_TOPE); int* tr = (int*)(c.ws + WS_TOPR);
      for (int row = lo + w0; row < hi; row += nw) if (c.lane < 4) { const size_t i = (size_t)row * 4 + c.lane; tr[i] = tr[i] + lbase[te[i]]; } }
    __syncthreads();
}
DEV void moe_table(const Ctx& c, int layer) {
    int* tab = (int*)(c.lds + LDS_TAB);
    __syncthreads();
    if (c.tid == 0) { const int* cnt = (const int*)(c.ws + WS_CTL + CTL_CNT) + layer * NE; int a = 0; for (int e = 0; e < NE; ++e) { tab[e] = a; a += (cnt[e] + MOE_BM - 1) / MOE_BM; } tab[NE] = a; }
    __syncthreads();
    for (int mt = c.tid; mt < tab[NE]; mt += NT) { int e = 0; for (int q = 1; q < NE; ++q) e = (tab[q] <= mt) ? q : e; tab[64 + mt] = e; }
    __syncthreads();
}
DEV void moe_scatter_phase(const Ctx& c, int layer, int lo, int hi) {
    moe_table(c, layer);
    const int* tab = (const int*)(c.lds + LDS_TAB);
    const int* te = (const int*)(c.ws + WS_TOPE); const float* tg = (const float*)(c.ws + WS_TOPG); const int* tr = (const int*)(c.ws + WS_TOPR);
    int* ps = (int*)(c.ws + WS_PSLOT); int* stok = (int*)(c.ws + WS_STOK); float* sg = (float*)(c.ws + WS_SGATE);
    for (size_t i = (size_t)lo * 4 + (size_t)c.blk * NT + c.tid; i < (size_t)hi * 4; i += (size_t)c.nblk * NT) {
        const int slot = tab[te[i]] * MOE_BM + tr[i];
        ps[i] = slot; stok[slot] = (int)(i >> 2); sg[slot] = tg[i];
    }
    __syncthreads();
}
DEV int moe_find_expert(const int* tab, int mt) { return tab[64 + mt]; }
constexpr int MOE_LDS_ROWS = LDS_TAB + 4096, MOE_LDS_UNITS = 19;
struct MoeSched {
    const int* tab; const int* rowidx; const int* ldsrows; const bf16_t* W; int nN, Nw, K, blk, nblk, tid;
    DEV bool next(int i, GUnit& u) const {
        int mt, pn; if (!xcd_deal(i, blk, nblk, tab[NE], nN, mt, pn)) return false;
        const int e = moe_find_expert(tab, mt);
        u.m0 = mt * MOE_BM; u.n0 = pn * G_BM; u.aux = e; u.bptr = (const char*)(W + ((size_t)e * Nw + u.n0) * K);
        g_fill_aoff(u, K, tid, ldsrows ? ldsrows + i * 256 : (rowidx ? rowidx + u.m0 : nullptr), u.m0); return true; }
};
DEV void moe_gemm1_phase(const Ctx& c, int layer) {
    moe_table(c, layer);
    const int* tab = (const int*)(c.lds + LDS_TAB);
    const int* stok = (const int*)(c.ws + WS_STOK);
    int* lrows = (int*)(c.lds + MOE_LDS_ROWS);
    const int nN = 2 * FF / G_BM;
    int nun = 0; { int mt, pn; while (nun <= MOE_LDS_UNITS && xcd_deal(nun, c.blk, c.nblk, tab[NE], nN, mt, pn)) ++nun; }
    const bool use_lds = nun <= MOE_LDS_UNITS;
    if (use_lds) { for (int i = 0; i < nun; ++i) { int mt, pn; xcd_deal(i, c.blk, c.nblk, tab[NE], nN, mt, pn); if (c.tid < 256) lrows[i * 256 + c.tid] = stok[mt * MOE_BM + c.tid]; } }
    __syncthreads();
    MoeSched S{tab, stok, use_lds ? lrows : nullptr, (const bf16_t*)(c.ws + WS_WGU) + (size_t)layer * NE * 2 * FF * DM, nN, 2 * FF, DM, c.blk, c.nblk, c.tid};
    EpiSwiglu E{(bf16_t*)(c.ws + WS_ACT), c.p->in[I_BGU] + (size_t)layer * NE * 2 * FF, c.pscale};
    gemm_phase(c.lds, (const bf16_t*)(c.ws + WS_HB), DM, S, E);
}
DEV void moe_gemm2_phase(const Ctx& c, int layer) {
    moe_table(c, layer);
    const int* tab = (const int*)(c.lds + LDS_TAB);
    MoeSched S{tab, nullptr, nullptr, (const bf16_t*)(c.ws + WS_WDN) + (size_t)layer * NE * DM * FF, DM / G_BM, DM, FF, c.blk, c.nblk, c.tid};
    EpiMoeDown E{(bf16_t*)(c.ws + WS_PO), c.p->in[I_BDN] + (size_t)layer * NE * DM, (const float*)(c.ws + WS_SGATE), c.pscale};
    gemm_phase(c.lds, (const bf16_t*)(c.ws + WS_ACT), FF, S, E);
}

DEV int seq_len(int s) { return s < BATCH ? CTX_LEN : SEQ; }
DEV int seq_row0(int s) { return s < BATCH ? s * CTX_LEN : NCTX + (s - BATCH) * SEQ; }
DEV void tile_to_seq(int tt, int& s, int& t0) { if (tt < NCTX / 64) { s = tt / (CTX_LEN / 64); t0 = (tt % (CTX_LEN / 64)) * 64; } else { const int r = tt - NCTX / 64; s = BATCH + r / (SEQ / 64); t0 = (r % (SEQ / 64)) * 64; } }

DEV void hy_conv_phase(const Ctx& c, int hj, int tile_lo, int tile_hi) {
    bf16_t* zt = (bf16_t*)c.lds;
    const bf16_t* U = (const bf16_t*)(c.ws + WS_MIX + MX_U); bf16_t* X0 = (bf16_t*)(c.ws + WS_MIX + MX_X0); bf16_t* ZT = (bf16_t*)(c.ws + WS_MIX + MX_ZT);
    const float* cw = c.p->in[I_HYCW] + (size_t)hj * 3 * 3 * DM; const float* cb = c.p->in[I_HYCB] + (size_t)hj * 3 * DM;
    constexpr int NST = (CTX_LEN % 256 == 0 && SEQ % 256 == 0) ? 4 : ((CTX_LEN % 128 == 0 && SEQ % 128 == 0) ? 2 : 1);
    const int nct = DM / 64, units = ((tile_hi - tile_lo) / NST) * nct;
    const int tl = c.tid >> 3, cg = c.tid & 7;
    for (int u = c.blk; u < units; u += c.nblk) {
        const int c0 = (u % nct) * 64 + cg * 8;
        f32x4 wb[3][2], ww[3][3][2];
#pragma unroll
        for (int gi = 0; gi < 3; ++gi) { const int ch = gi * DM + c0; wb[gi][0] = *(const f32x4*)(cb + ch); wb[gi][1] = *(const f32x4*)(cb + ch + 4);
#pragma unroll
            for (int j = 0; j < 3; ++j) { ww[gi][j][0] = *(const f32x4*)(cw + (size_t)j * 3 * DM + ch); ww[gi][j][1] = *(const f32x4*)(cw + (size_t)j * 3 * DM + ch + 4); } }
        bf16x8 rv[3][3], rn[3][3];
        { int s, t0; tile_to_seq(tile_lo + (u / nct) * NST, s, t0); const int L = seq_len(s), r0 = seq_row0(s), t = t0 + tl;
#pragma unroll
          for (int gi = 0; gi < 3; ++gi)
#pragma unroll
              for (int j = 0; j < 3; ++j) { const int ts = t + j - 1; rv[gi][j] = (ts < 0 || ts >= L) ? zero8() : ld8(U + (size_t)(r0 + ts) * 3 * DM + gi * DM + c0); } }
#pragma unroll 1
        for (int st = 0; st < NST; ++st) {
            int s, t0; tile_to_seq(tile_lo + (u / nct) * NST + st, s, t0);
            const int L = seq_len(s), r0 = seq_row0(s), t = t0 + tl;
            if (st + 1 < NST) { int s2, t2; tile_to_seq(tile_lo + (u / nct) * NST + st + 1, s2, t2); const int L2 = seq_len(s2), r2 = seq_row0(s2), tn = t2 + tl;
#pragma unroll
                for (int gi = 0; gi < 3; ++gi)
#pragma unroll
                    for (int j = 0; j < 3; ++j) { const int ts = tn + j - 1; rn[gi][j] = (ts < 0 || ts >= L2) ? zero8() : ld8(U + (size_t)(r2 + ts) * 3 * DM + gi * DM + c0); } }
            float o[3][8];
#pragma unroll
            for (int gi = 0; gi < 3; ++gi) {
#pragma unroll
                for (int q = 0; q < 4; ++q) { o[gi][q] = wb[gi][0][q]; o[gi][4 + q] = wb[gi][1][q]; }
#pragma unroll
                for (int j = 0; j < 3; ++j) { const bf16x8 v = rv[gi][j];
#pragma unroll
                    for (int q = 0; q < 4; ++q) { o[gi][q] += bf2f((bf16_t)v[q]) * ww[gi][j][0][q]; o[gi][4 + q] += bf2f((bf16_t)v[4 + q]) * ww[gi][j][1][q]; } } }
#pragma unroll
            for (int gi = 0; gi < 3; ++gi)
#pragma unroll
                for (int j = 0; j < 3; ++j) rv[gi][j] = rn[gi][j];
            u32x4 xo; xo[0] = pack2(o[0][0], o[0][1]); xo[1] = pack2(o[0][2], o[0][3]); xo[2] = pack2(o[0][4], o[0][5]); xo[3] = pack2(o[0][6], o[0][7]);
            *(u32x4*)(X0 + (size_t)(r0 + t) * DM + c0) = xo;
            __syncthreads();
#pragma unroll
            for (int q = 0; q < 8; ++q) zt[(cg * 8 + q) * 72 + tl] = f2bf(o[2][q] * o[1][q]);
            __syncthreads();
            { const int ch = c.tid >> 3, tc = (c.tid & 7) * 8;
              *(u32x4*)(ZT + (size_t)r0 * DM + (size_t)((u % nct) * 64 + ch) * L + t0 + tc) = *(const u32x4*)(zt + ch * 72 + tc); }
        }
    }
    __syncthreads();
}
template <int L>
DEV void hy_longconv_job(const Ctx& c, int job, int seq0  ) {
    constexpr int CPITCH = 2 * L * 2 + 32;
    constexpr int MTW = L / 128;
    unsigned char* cp = c.lds;
    const bf16_t* FR = (const bf16_t*)(c.ws + WS_FR) + (size_t)job * DM * 2 * SEQ;
    const bf16_t* ZT = (const bf16_t*)(c.ws + WS_MIX + MX_ZT); bf16_t* YT = (bf16_t*)(c.ws + WS_MIX + MX_YT);
    const int fr = c.lane & 15, fq = c.lane >> 4;
    for (int d = c.blk; d < DM; d += c.nblk) {
        __syncthreads();
        const bf16_t* R = FR + (size_t)d * 2 * L;
        for (int i = c.tid; i < 8 * 2 * L; i += NT) { const int cc = i / (2 * L), idx = i % (2 * L); *(bf16_t*)(cp + cc * CPITCH + idx * 2) = R[(idx - cc + 2 * L) % (2 * L)]; }
        __syncthreads();
        f32x4 acc[MTW];
#pragma unroll
        for (int m = 0; m < MTW; ++m) acc[m] = (f32x4){0.f, 0.f, 0.f, 0.f};
        const bool bval = fr < BATCH;
        const bf16_t* zrow = ZT + (size_t)seq_row0(seq0 + (bval ? fr : 0)) * DM + (size_t)d * L;
        const int a = fr >> 3, cc = fr & 7;
        if constexpr (MTW == 16) {
            auto afrag = [&](int delta) { const int base = (16 * delta + 8 * (fq - a) - c.wave * 256 + 4 * L) % (2 * L); return ld8(cp + cc * CPITCH + base * 2); };
            bf16x8 win[16];
#pragma unroll
            for (int j = 0; j < 16; ++j) win[j] = afrag(-j);
            for (int kt0 = 0; kt0 < L / 32; kt0 += 8) {
#pragma unroll
                for (int kk = 0; kk < 8; ++kk) {
                    const int kt = kt0 + kk;
                    const bf16x8 bfrag = bval ? ld8(zrow + kt * 32 + 8 * fq) : zero8();
#pragma unroll
                    for (int m = 0; m < 16; ++m) acc[m] = mfma16(win[(m - 2 * kk) & 15], bfrag, acc[m]);
                    win[(0 - 2 * (kk + 1)) & 15] = afrag(2 * kt + 2); win[(1 - 2 * (kk + 1)) & 15] = afrag(2 * kt + 1);
                }
            }
        } else {
        for (int kt = 0; kt < L / 32; ++kt) {
            const int s0 = kt * 32;
            const bf16x8 bfrag = bval ? ld8(zrow + s0 + 8 * fq) : zero8();
#pragma unroll
            for (int m = 0; m < MTW; ++m) {
                const int t0 = (c.wave * MTW + m) * 16;
                const int base = (s0 - t0 + 8 * (fq - a) + 2 * L) % (2 * L);
                const bf16x8 afrag = ld8(cp + cc * CPITCH + base * 2);
                acc[m] = mfma16(afrag, bfrag, acc[m]);
            }
        }
        }
        if (bval) {
            bf16_t* yrow = YT + (size_t)seq_row0(seq0 + fr) * DM + (size_t)d * L;
#pragma unroll
            for (int m = 0; m < MTW; ++m) { const int t = (c.wave * MTW + m) * 16 + 4 * fq; u32x2 w; w[0] = pack2(acc[m][0], acc[m][1]); w[1] = pack2(acc[m][2], acc[m][3]); *(u32x2*)(yrow + t) = w; }
        }
    }
    __syncthreads();
}
DEV void hy_gate_phase(const Ctx& c, int tile_lo, int tile_hi) {
    bf16_t* yt = (bf16_t*)c.lds;
    const bf16_t* YT = (const bf16_t*)(c.ws + WS_MIX + MX_YT); const bf16_t* X0 = (const bf16_t*)(c.ws + WS_MIX + MX_X0); bf16_t* HB = (bf16_t*)(c.ws + WS_HB);
    const int nct = DM / 64, units = (tile_hi - tile_lo) * nct;
    for (int u = c.blk; u < units; u += c.nblk) {
        int s, t0; tile_to_seq(tile_lo + u / nct, s, t0); const int cb0 = (u % nct) * 64; const int L = seq_len(s), r0 = seq_row0(s);
        __syncthreads();
        { const int ch = c.tid >> 3, tc = (c.tid & 7) * 8; *(u32x4*)(yt + ch * 72 + tc) = *(const u32x4*)(YT + (size_t)r0 * DM + (size_t)(cb0 + ch) * L + t0 + tc); }
        __syncthreads();
        { const int tl = c.tid >> 3, cg = c.tid & 7; const bf16x8 x0 = ld8(X0 + (size_t)(r0 + t0 + tl) * DM + cb0 + cg * 8); float o[8];
#pragma unroll
          for (int q = 0; q < 8; ++q) o[q] = bf2f(yt[(cg * 8 + q) * 72 + tl]) * bf2f((bf16_t)x0[q]);
          u32x4 w; w[0] = pack2(o[0], o[1]); w[1] = pack2(o[2], o[3]); w[2] = pack2(o[4], o[5]); w[3] = pack2(o[6], o[7]);
          *(u32x4*)(HB + (size_t)(r0 + t0 + tl) * DM + cb0 + cg * 8) = w; }
    }
    __syncthreads();
}

constexpr int S5_T = 8, S5_NCH = (CTX_LEN + SEQ) / S5_T, S5_SEGC = S5_NCH / 8;
constexpr int S5_OFF_F = 0, S5_OFF_E = 32768, S5_OFF_K = 65536, S5_OFF_LT = S5_OFF_K + 4096, S5_OFF_LS = S5_OFF_LT + 512, S5_OFF_SEG = S5_OFF_LS + 512;
DEV int s5_row(int b, int n, int dr) { return n < CTX_LEN ? b * CTX_LEN + (dr ? CTX_LEN - 1 - n : n) : NCTX + b * SEQ + (dr ? SEQ - 1 - (n - CTX_LEN) : n - CTX_LEN); }
DEV void s5_scan_phase(const Ctx& c) {
    static_assert(S5_NCH % 8 == 0 && CTX_LEN % S5_T == 0, "s5 segments");
    const bf16_t* HB = (const bf16_t*)(c.ws + WS_HB); float* YS = (float*)(c.ws + WS_MIX + MX_YS);
    unsigned char* lds = c.lds;
    bf16_t* Ft = (bf16_t*)(lds + S5_OFF_F); bf16_t* Et = (bf16_t*)(lds + S5_OFF_E); bf16_t* Kt = (bf16_t*)(lds + S5_OFF_K);
    float* lamT = (float*)(lds + S5_OFF_LT); float* lamS = (float*)(lds + S5_OFF_LS); float* seg = (float*)(lds + S5_OFF_SEG);
    float* lamp = seg;
    float* bbar = seg + 1024;
    float* lam1 = seg + 1024 + 2048;
    const int lane = c.lane, wave = c.wave, fr = lane & 15, fq = lane >> 4;
    const int units = S5G * 2;
    for (int u = c.blk; u < units; u += c.nblk) {
        const int dr = u & 1, g = u >> 1;
        __syncthreads();
        if (c.tid < 64) { const int p = c.tid; const size_t gp = ((size_t)dr * S5G + g) * 64 + p;
            const float are = c.p->in[I_S5ARE][gp], aim = c.p->in[I_S5AIM][gp], step = expf(c.p->in[I_S5LS][dr * S5G + g]);
            lam1[2 * p] = are * step; lam1[2 * p + 1] = aim * step;
            const float mag = expf(are * step), lre = mag * fcos_(aim * step), lim = mag * fsin_(aim * step);
            const float nr = lre - 1.f, ni = lim, dn = are * are + aim * aim, f_r = (nr * are + ni * aim) / dn, f_i = (ni * are - nr * aim) / dn;
            for (int h = 0; h < 16; ++h) { const float br = c.p->in[I_S5BRE][gp * 16 + h], bi = c.p->in[I_S5BIM][gp * 16 + h]; bbar[(p * 16 + h) * 2] = f_r * br - f_i * bi; bbar[(p * 16 + h) * 2 + 1] = f_r * bi + f_i * br; }
            for (int t = 0; t < 8; ++t) { const float m = expf(are * step * (float)t); lamp[(t * 64 + p) * 2] = m * fcos_(aim * step * (float)t); lamp[(t * 64 + p) * 2 + 1] = m * fsin_(aim * step * (float)t); }
            { const float m = expf(are * step * (float)S5_T); lamT[2 * p] = m * fcos_(aim * step * (float)S5_T); lamT[2 * p + 1] = m * fsin_(aim * step * (float)S5_T); }
            { const double ang = (double)aim * (double)step * (double)(S5_T * S5_SEGC); const float m = expf(are * step * (float)(S5_T * S5_SEGC)); lamS[2 * p] = m * (float)cos(ang); lamS[2 * p + 1] = m * (float)sin(ang); }
        }
        __syncthreads();
        for (int i = c.tid; i < 8 * 4 * 64 * 8; i += NT) { const int j = i & 7, ln = (i >> 3) & 63, kk = (i >> 9) & 3, m = i >> 11; const int lf = ln & 15, lq = ln >> 4;
            const int p = 16 * (m & 3) + lf, s = 2 * kk + (lq >> 1), hh = 8 * (lq & 1) + j, pw = S5_T - 1 - s;
            const float lr = lamp[(pw * 64 + p) * 2], li = lamp[(pw * 64 + p) * 2 + 1], br = bbar[(p * 16 + hh) * 2], bi = bbar[(p * 16 + hh) * 2 + 1];
            Ft[i] = f2bf(m < 4 ? lr * br - li * bi : lr * bi + li * br); }
        for (int i = c.tid; i < 8 * 4 * 64 * 8; i += NT) { const int j = i & 7, ln = (i >> 3) & 63, kk = (i >> 9) & 3, t = i >> 11; const int lf = ln & 15, lq = ln >> 4;
            const int rho = 32 * kk + 16 * (j >> 2) + 4 * lq + (j & 3), p = rho & 63; const size_t ci = (((size_t)dr * S5G + g) * 16 + lf) * 64 + p;
            const float cr = c.p->in[I_S5CRE][ci], cim = c.p->in[I_S5CIM][ci];
            const float mg = expf(lam1[2 * p] * (float)(t + 1)), lr = mg * fcos_(lam1[2 * p + 1] * (float)(t + 1)), li = mg * fsin_(lam1[2 * p + 1] * (float)(t + 1));
            Et[i] = f2bf(rho < 64 ? cr * lr - cim * li : -(cr * li + cim * lr)); }
        for (int i = c.tid; i < 8 * 256; i += NT) { const int hh = i & 15, h = (i >> 4) & 15, tau = i >> 8; float a = 0.f;
            for (int p = 0; p < 64; ++p) { const size_t ci = (((size_t)dr * S5G + g) * 16 + h) * 64 + p; const float cr = c.p->in[I_S5CRE][ci], cim = c.p->in[I_S5CIM][ci];
                const float lr = lamp[(tau * 64 + p) * 2], li = lamp[(tau * 64 + p) * 2 + 1], br = bbar[(p * 16 + hh) * 2], bi = bbar[(p * 16 + hh) * 2 + 1];
                const float zr = lr * br - li * bi, zi = lr * bi + li * br; a += cr * zr - cim * zi; }
            Kt[i] = f2bf(a); }
        __syncthreads();
        const bool bval = fr < BATCH;
        float ltr[16], lti[16];
#pragma unroll
        for (int m = 0; m < 4; ++m)
#pragma unroll
            for (int jj = 0; jj < 4; ++jj) { const int p = 16 * m + 4 * fq + jj; ltr[m * 4 + jj] = lamT[2 * p]; lti[m * 4 + jj] = lamT[2 * p + 1]; }
        f32x4 xs[8];
#pragma unroll
        for (int m = 0; m < 8; ++m) xs[m] = (f32x4){0.f, 0.f, 0.f, 0.f};
        const int ch0 = wave * S5_SEGC;
#pragma unroll 1
        for (int pass = 0; pass < 2; ++pass) {
            if (pass == 1) {
#pragma unroll
                for (int m = 0; m < 8; ++m) *(f32x4*)(seg + ((wave * 8 + m) * 64 + lane) * 4) = xs[m];
                __syncthreads();
#pragma unroll
                for (int m = 0; m < 8; ++m) xs[m] = (f32x4){0.f, 0.f, 0.f, 0.f};
                for (int v = 0; v < wave; ++v) {
#pragma unroll
                    for (int m = 0; m < 4; ++m) { const f32x4 er = *(const f32x4*)(seg + ((v * 8 + m) * 64 + lane) * 4), ei = *(const f32x4*)(seg + ((v * 8 + m + 4) * 64 + lane) * 4);
#pragma unroll
                        for (int jj = 0; jj < 4; ++jj) { const int p = 16 * m + 4 * fq + jj; const float lr = lamS[2 * p], li = lamS[2 * p + 1]; const float xr = xs[m][jj], xi = xs[m + 4][jj];
                            xs[m][jj] = lr * xr - li * xi + er[jj]; xs[m + 4][jj] = lr * xi + li * xr + ei[jj]; } }
                }
            }
#pragma unroll 1
            for (int cc = 0; cc < S5_SEGC; ++cc) {
                const int n0 = (ch0 + cc) * S5_T;
                bf16x8 uf[4];
#pragma unroll
                for (int kk = 0; kk < 4; ++kk) uf[kk] = bval ? ld8(HB + (size_t)s5_row(fr, n0 + 2 * kk + (fq >> 1), dr) * DM + g * 16 + 8 * (fq & 1)) : zero8();
                if (pass == 1) {
                    bf16x8 xf[4];
#pragma unroll
                    for (int kk = 0; kk < 4; ++kk) { u32x4 w; w[0] = pack2(xs[2 * kk][0], xs[2 * kk][1]); w[1] = pack2(xs[2 * kk][2], xs[2 * kk][3]); w[2] = pack2(xs[2 * kk + 1][0], xs[2 * kk + 1][1]); w[3] = pack2(xs[2 * kk + 1][2], xs[2 * kk + 1][3]); xf[kk] = __builtin_bit_cast(bf16x8, w); }
#pragma unroll
                    for (int t = 0; t < 8; ++t) { f32x4 y = {0.f, 0.f, 0.f, 0.f};
#pragma unroll
                        for (int kk = 0; kk < 4; ++kk) y = mfma16(ld8(Et + ((t * 4 + kk) * 64 + lane) * 8), xf[kk], y);
#pragma unroll
                        for (int kk = 0; kk < 4; ++kk) if (2 * kk <= t) { const int tau = t - 2 * kk - (fq >> 1); const bf16x8 kf = tau >= 0 ? ld8(Kt + (tau * 16 + fr) * 16 + 8 * (fq & 1)) : zero8(); y = mfma16(kf, uf[kk], y); }
                        if (bval) *(f32x4*)(YS + ((size_t)dr * NTOK + s5_row(fr, n0 + t, dr)) * DM + g * 16 + 4 * fq) = y;
                        SCHED_FENCE(); }
                }
#pragma unroll
                for (int m = 0; m < 4; ++m) { f32x4 sr = {0.f, 0.f, 0.f, 0.f}, si = {0.f, 0.f, 0.f, 0.f};
#pragma unroll
                    for (int kk = 0; kk < 4; ++kk) { sr = mfma16(ld8(Ft + ((m * 4 + kk) * 64 + lane) * 8), uf[kk], sr); si = mfma16(ld8(Ft + (((m + 4) * 4 + kk) * 64 + lane) * 8), uf[kk], si); }
#pragma unroll
                    for (int jj = 0; jj < 4; ++jj) { const float lr = ltr[m * 4 + jj], li = lti[m * 4 + jj]; const float xr = xs[m][jj], xi = xs[m + 4][jj];
                        xs[m][jj] = lr * xr - li * xi + sr[jj]; xs[m + 4][jj] = lr * xi + li * xr + si[jj]; }
                    SCHED_FENCE(); }
            }
        }
    }
    __syncthreads();
}
DEV void s5_finish_phase(const Ctx& c, int s5j) {
    const float* YS = (const float*)(c.ws + WS_MIX + MX_YS); bf16_t* HB = (bf16_t*)(c.ws + WS_HB);
    const float* dsk = c.p->in[I_S5D] + (size_t)s5j * DM;
    const size_t n4 = (size_t)NTOK * DM / 4;
    for (size_t i = (size_t)c.blk * NT + c.tid; i < n4; i += (size_t)c.nblk * NT) {
        const u32x2 hw = ((const u32x2*)HB)[i]; const float h[4] = {bf2f((bf16_t)(hw[0] & 0xffff)), bf2f((bf16_t)(hw[0] >> 16)), bf2f((bf16_t)(hw[1] & 0xffff)), bf2f((bf16_t)(hw[1] >> 16))};
        const f32x4 a = ((const f32x4*)YS)[i], b = ((const f32x4*)(YS + (size_t)NTOK * DM))[i]; const f32x4 dd = *(const f32x4*)(dsk + (i * 4) % DM);
        float o[4];
#pragma unroll
        for (int q = 0; q < 4; ++q) { const float x = a[q] + b[q] + dd[q] * h[q]; o[q] = 0.5f * x * (1.f + tanhf(0.7978845608028654f * (x + 0.044715f * x * x * x))); }
        u32x2 w; w[0] = pack2(o[0], o[1]); w[1] = pack2(o[2], o[3]); ((u32x2*)HB)[i] = w;
    }
}

DEV void ml_qkv_phase(const Ctx& c, int mj) {
    bf16_t* kt = (bf16_t*)c.lds; bf16_t* vt = kt + 64 * 72;
    const bf16_t* XMZ = (const bf16_t*)(c.ws + WS_MIX + MX_XMZ);
    bf16_t* Q = (bf16_t*)(c.ws + WS_MIX + MX_Q); bf16_t* Kb = (bf16_t*)(c.ws + WS_MIX + MX_K); bf16_t* V = (bf16_t*)(c.ws + WS_MIX + MX_V); bf16_t* XC = (bf16_t*)(c.ws + WS_MIX + MX_XC);
    bf16_t* KT = (bf16_t*)(c.ws + WS_MIX + MX_KT); bf16_t* VT = (bf16_t*)(c.ws + WS_MIX + MX_VT);
    const float* cw = c.p->in[I_MLCW] + (size_t)mj * 3 * DI; const float* cb = c.p->in[I_MLCB] + (size_t)mj * DI;
    const float* wq = c.p->in[I_MLWQ] + (size_t)mj * DI * 4; const float* wk = c.p->in[I_MLWK] + (size_t)mj * DI * 4; const float* wv = c.p->in[I_MLWV] + (size_t)mj * DI * 4;
    const float kscale = 1.f / sqrtf((float)DH);
    constexpr int NST = (CTX_LEN % 256 == 0 && SEQ % 256 == 0) ? 4 : ((CTX_LEN % 128 == 0 && SEQ % 128 == 0) ? 2 : 1);
    const int nct = DI / 64, units = (NTOK / (64 * NST)) * nct;
    const int tl = c.tid >> 3, cg = c.tid & 7;
    for (int u = c.blk; u < units; u += c.nblk) {
        const int cb0 = (u % nct) * 64, c0 = cb0 + cg * 8;
        f32x4 wc0[3], wc1[3], mq[2][4], mk[2][4], mv[2][4];
        const f32x4 b0 = *(const f32x4*)(cb + c0), b1 = *(const f32x4*)(cb + c0 + 4);
#pragma unroll
        for (int j = 0; j < 3; ++j) { wc0[j] = *(const f32x4*)(cw + (size_t)j * DI + c0); wc1[j] = *(const f32x4*)(cw + (size_t)j * DI + c0 + 4); }
#pragma unroll
        for (int blk = 0; blk < 2; ++blk) { const size_t wb = (size_t)((c0 >> 2) + blk) * 16;
#pragma unroll
            for (int i = 0; i < 4; ++i) { mq[blk][i] = *(const f32x4*)(wq + wb + i * 4); mk[blk][i] = *(const f32x4*)(wk + wb + i * 4); mv[blk][i] = *(const f32x4*)(wv + wb + i * 4); } }
        bf16x8 rv[3], rn[3];
        { int s, t0; tile_to_seq((u / nct) * NST, s, t0); const int L = seq_len(s), r0 = seq_row0(s), t = t0 + tl;
#pragma unroll
          for (int j = 0; j < 3; ++j) { const int ts = t + j - 1; rv[j] = (ts < 0 || ts >= L) ? zero8() : ld8(XMZ + (size_t)(r0 + ts) * 2 * DI + c0); } }
#pragma unroll 1
        for (int st = 0; st < NST; ++st) {
            int s, t0; tile_to_seq((u / nct) * NST + st, s, t0); const int r0 = seq_row0(s), t = t0 + tl;
            if (st + 1 < NST) { int s2, t2; tile_to_seq((u / nct) * NST + st + 1, s2, t2); const int L2 = seq_len(s2), r2 = seq_row0(s2), tn = t2 + tl;
#pragma unroll
                for (int j = 0; j < 3; ++j) { const int ts = tn + j - 1; rn[j] = (ts < 0 || ts >= L2) ? zero8() : ld8(XMZ + (size_t)(r2 + ts) * 2 * DI + c0); } }
            float xm[8], xc[8];
#pragma unroll
            for (int q = 0; q < 4; ++q) { xc[q] = b0[q]; xc[4 + q] = b1[q]; }
#pragma unroll
            for (int j = 0; j < 3; ++j) { const bf16x8 v = rv[j];
#pragma unroll
                for (int q = 0; q < 8; ++q) { const float f = bf2f((bf16_t)v[q]); xc[q] += f * (q < 4 ? wc0[j][q & 3] : wc1[j][q & 3]); if (j == 1) xm[q] = f; } }
#pragma unroll
            for (int j = 0; j < 3; ++j) rv[j] = rn[j];
#pragma unroll
            for (int q = 0; q < 8; ++q) xc[q] = siluf_(xc[q]);
            float qo[8], ko[8], vo[8];
#pragma unroll
            for (int blk = 0; blk < 2; ++blk)
#pragma unroll
                for (int o = 0; o < 4; ++o) { float aq = 0.f, ak = 0.f, av = 0.f;
#pragma unroll
                    for (int i = 0; i < 4; ++i) { aq += xc[blk * 4 + i] * mq[blk][i][o]; ak += xc[blk * 4 + i] * mk[blk][i][o]; av += xm[blk * 4 + i] * mv[blk][i][o]; }
                    qo[blk * 4 + o] = aq; ko[blk * 4 + o] = ak * kscale; vo[blk * 4 + o] = av; }
            const size_t ro = (size_t)(r0 + t) * DI + c0; u32x4 w;
            w[0] = pack2(qo[0], qo[1]); w[1] = pack2(qo[2], qo[3]); w[2] = pack2(qo[4], qo[5]); w[3] = pack2(qo[6], qo[7]); *(u32x4*)(Q + ro) = w;
            w[0] = pack2(ko[0], ko[1]); w[1] = pack2(ko[2], ko[3]); w[2] = pack2(ko[4], ko[5]); w[3] = pack2(ko[6], ko[7]); *(u32x4*)(Kb + ro) = w;
            w[0] = pack2(vo[0], vo[1]); w[1] = pack2(vo[2], vo[3]); w[2] = pack2(vo[4], vo[5]); w[3] = pack2(vo[6], vo[7]); *(u32x4*)(V + ro) = w;
            w[0] = pack2(xc[0], xc[1]); w[1] = pack2(xc[2], xc[3]); w[2] = pack2(xc[4], xc[5]); w[3] = pack2(xc[6], xc[7]); *(u32x4*)(XC + ro) = w;
            __syncthreads();
#pragma unroll
            for (int q = 0; q < 8; ++q) { kt[(cg * 8 + q) * 72 + tl] = f2bf(ko[q]); vt[(cg * 8 + q) * 72 + tl] = f2bf(vo[q]); }
            __syncthreads();
            { const int ch = c.tid >> 3, tc = (c.tid & 7) * 8; const size_t o = (size_t)(r0 + t0) * DI + (size_t)(cb0 + ch) * 64 + tc;
              *(u32x4*)(KT + o) = *(const u32x4*)(kt + ch * 72 + tc); *(u32x4*)(VT + o) = *(const u32x4*)(vt + ch * 72 + tc); }
        }
    }
    __syncthreads();
}
DEV void ml_gates_phase(const Ctx& c, int mj) {
    const bf16_t* Q = (const bf16_t*)(c.ws + WS_MIX + MX_Q); const bf16_t* Kb = (const bf16_t*)(c.ws + WS_MIX + MX_K); const bf16_t* V = (const bf16_t*)(c.ws + WS_MIX + MX_V);
    const bf16_t* GW = (const bf16_t*)(c.ws + WS_GW); float* GATE = (float*)(c.ws + WS_MIX + MX_GATE);
    const int fr = c.lane & 15, fq = c.lane >> 4;
    const int dr = fr >> 3, gate = (fr >> 2) & 1, head = fr & 3;
    const float bias = (gate ? c.p->in[I_MLFGB] : c.p->in[I_MLIGB])[((size_t)mj * 2 + dr) * NH + head];
    constexpr int NSTEP = 3 * DI / 32, SPW = NSTEP / 8, SPP = DI / 32;
    static_assert(NSTEP % 8 == 0, "gate k-steps per wave");
    f32x4* red = (f32x4*)c.lds;
    for (int u = c.blk; u < NTOK / 16; u += c.nblk) {
        f32x4 acc = {0.f, 0.f, 0.f, 0.f};
        const size_t ro = (size_t)(u * 16 + fr) * DI;
#pragma unroll
        for (int i = 0; i < SPW; ++i) { const int s = c.wave * SPW + i, part = s / SPP, k = (s % SPP) * 32;
            const bf16_t* A = (part == 0 ? Q : part == 1 ? Kb : V) + ro + k + 8 * fq; const bf16_t* B = GW + (size_t)fr * 3 * DI + part * DI + k + 8 * fq;
            acc = mfma16(ld8(A), ld8(B), acc); }
        __syncthreads();
        red[c.wave * 64 + c.lane] = acc;
        __syncthreads();
        if (c.wave == 0) { f32x4 s = red[c.lane];
#pragma unroll
            for (int w = 1; w < 8; ++w) s = s + red[w * 64 + c.lane];
#pragma unroll
            for (int j = 0; j < 4; ++j) GATE[(size_t)(u * 16 + 4 * fq + j) * 16 + fr] = s[j] + bias; }
    }
    __syncthreads();
}
constexpr int ML_NCC = CTX_LEN / 64, ML_NLC = SEQ / 64, ML_NCH = ML_NCC + ML_NLC;
DEV void ml_prep_phase(const Ctx& c) {
    const bf16_t* Q = (const bf16_t*)(c.ws + WS_MIX + MX_Q); const bf16_t* Kb = (const bf16_t*)(c.ws + WS_MIX + MX_K);
    const float* GATE = (const float*)(c.ws + WS_MIX + MX_GATE);
    float* GQ = (float*)(c.ws + WS_MIX + MX_GQ); float* GWT = (float*)(c.ws + WS_MIX + MX_GWT); float* DEC = (float*)(c.ws + WS_MIX + MX_DEC); bf16_t* P = (bf16_t*)(c.ws + WS_MIX + MX_P);
    float* gG = (float*)c.lds; float* gI = gG + 128; bf16_t* pt = (bf16_t*)(c.lds + 1024); float* rsum = (float*)(c.lds + 1024 + 2 * 64 * 72 * 2);
    constexpr int ML_PP = DH * 2 + 16; unsigned char* ldsQK = c.lds + 21760;
    const int fr = c.lane & 15, fq = c.lane >> 4, wave = c.wave, tt = wave >> 1, nh2 = wave & 1;
    constexpr int KD = DH / 32;
    const int units = BATCH * NH * ML_NCH;
    for (int u = c.blk; u < units; u += c.nblk) {
        const int k = u % ML_NCH, head = (u / ML_NCH) % NH, b = u / (ML_NCH * NH);
        const bool isctx = k < ML_NCC; const int ci = isctx ? k : k - ML_NCC; const int r0 = isctx ? b * CTX_LEN : NCTX + b * SEQ; const int rc = r0 + ci * 64;
        __syncthreads();
        if (wave < 2) {
            const int dr = wave, r = c.lane; const float fg = GATE[(size_t)(rc + r) * 16 + dr * 8 + 4 + head], ig = GATE[(size_t)(rc + r) * 16 + dr * 8 + head];
            const float lf = fminf(fg, 0.f) - log1pf(expf(-fabsf(fg)));
            float cum = lf;
#pragma unroll
            for (int o = 1; o < 64; o <<= 1) { const float nb = dr ? __shfl_down(cum, o) : __shfl_up(cum, o); const bool ok = dr ? (r + o < 64) : (r - o >= 0); cum += ok ? nb : 0.f; }
            const float tot = __shfl(cum, dr ? 0 : 63);
            gG[dr * 64 + r] = cum; gI[dr * 64 + r] = ig;
            GQ[((size_t)dr * NH + head) * NTOK + rc + r] = expf(cum); GWT[((size_t)dr * NH + head) * NTOK + rc + r] = expf(tot - cum + ig);
            if (r == 0) DEC[(((size_t)dr * BATCH + b) * NH + head) * ML_NCH + k] = expf(tot);
        }
        __syncthreads();
        {
            const int L = isctx ? CTX_LEN : SEQ; const bf16_t* KTs = (const bf16_t*)(c.ws + WS_MIX + MX_KT); bf16_t* KTW = (bf16_t*)(c.ws + WS_MIX + MX_KTW);
            const int sc = (c.tid & 7) * 8;
            float w0[8], w1[8];
#pragma unroll
            for (int q = 0; q < 8; ++q) { w0[q] = expf(gG[63] - gG[sc + q] + gI[sc + q]); w1[q] = expf(gG[64] - gG[64 + sc + q] + gI[64 + sc + q]); }
#pragma unroll
            for (int d = c.tid >> 3; d < DH; d += NT / 8) { const size_t o = (size_t)rc * DI + (size_t)(head * DH + d) * 64 + sc;
                const bf16x8 kv = ld8(KTs + o); float f[8];
#pragma unroll
                for (int q = 0; q < 8; ++q) f[q] = bf2f((bf16_t)kv[q]);
                u32x4 a, bb;
#pragma unroll
                for (int q = 0; q < 4; ++q) { a[q] = pack2(f[2 * q] * w0[2 * q], f[2 * q + 1] * w0[2 * q + 1]); bb[q] = pack2(f[2 * q] * w1[2 * q], f[2 * q + 1] * w1[2 * q + 1]); }
                *(u32x4*)(KTW + o) = a; *(u32x4*)(KTW + (size_t)NTOK * DI + o) = bb;
                float s0 = 0.f, s1 = 0.f;
#pragma unroll
                for (int q = 0; q < 8; ++q) { s0 += f[q] * w0[q]; s1 += f[q] * w1[q]; }
                s0 += __shfl_xor(s0, 1); s1 += __shfl_xor(s1, 1); s0 += __shfl_xor(s0, 2); s1 += __shfl_xor(s1, 2); s0 += __shfl_xor(s0, 4); s1 += __shfl_xor(s1, 4);
                if ((c.tid & 7) == 0) { float* KS = (float*)(c.ws + WS_MIX + MX_KS); KS[((((size_t)0 * BATCH + b) * NH + head) * ML_NCH + k) * DH + d] = s0; KS[((((size_t)1 * BATCH + b) * NH + head) * ML_NCH + k) * DH + d] = s1; } }
        }
        if (!isctx) {
            f32x4 sacc[2] = {(f32x4){0.f, 0.f, 0.f, 0.f}, (f32x4){0.f, 0.f, 0.f, 0.f}};
            { constexpr int QPT = DH / 64; const int r = c.tid >> 3, cl = (c.tid & 7) * 8; const bf16_t* qg = Q + (size_t)(rc + r) * DI + head * DH + cl; const bf16_t* kg = Kb + (size_t)(rc + r) * DI + head * DH + cl;
#pragma unroll
              for (int i = 0; i < QPT; ++i) { *(u32x4*)(ldsQK + r * ML_PP + (cl + 64 * i) * 2) = *(const u32x4*)(qg + 64 * i); *(u32x4*)(ldsQK + 64 * ML_PP + r * ML_PP + (cl + 64 * i) * 2) = *(const u32x4*)(kg + 64 * i); } }
            __syncthreads();
            { const unsigned lo = (unsigned)(fr * ML_PP + 16 * fq); const unsigned char* qb = ldsQK + (tt * 16) * ML_PP; const unsigned char* kb0 = ldsQK + 64 * ML_PP + ((2 * nh2) * 16) * ML_PP;
#pragma unroll
              for (int kk = 0; kk < KD; ++kk) { const bf16x8 qa = ldo(qb + kk * 64, lo); sacc[0] = mfma16(qa, ldo(kb0 + kk * 64, lo), sacc[0]); sacc[1] = mfma16(qa, ldo(kb0 + 16 * ML_PP + kk * 64, lo), sacc[1]); } }
#pragma unroll
            for (int dr = 0; dr < 2; ++dr)
#pragma unroll
                for (int n = 0; n < 2; ++n) { const int s = (2 * nh2 + n) * 16 + fr; const float gs = gG[dr * 64 + s], is_ = gI[dr * 64 + s];
#pragma unroll
                    for (int j = 0; j < 4; ++j) { const int t = tt * 16 + 4 * fq + j; const bool ok = dr ? (s >= t) : (s <= t);
                        const float pv = ok ? sacc[n][j] * expf(gG[dr * 64 + t] - gs + is_) : 0.f;
                        pt[(dr * 64 + t) * 72 + s] = f2bf(pv);
                        float rs = pv; rs += __shfl_xor(rs, 1); rs += __shfl_xor(rs, 2); rs += __shfl_xor(rs, 4); rs += __shfl_xor(rs, 8);
                        if (fr == 0) rsum[((dr * 64 + t) * 2 + nh2) * 2 + n] = rs; } }
            __syncthreads();
            if (c.tid < 128) { const int dr = c.tid >> 6, t = c.tid & 63; const float* r4 = rsum + (dr * 64 + t) * 4;
                ((float*)(c.ws + WS_MIX + MX_RP))[((size_t)dr * NLAT + (rc - NCTX + t)) * NH + head] = (r4[0] + r4[1]) + (r4[2] + r4[3]); }
#pragma unroll
            for (int i = 0; i < 2; ++i) { const int e = c.tid + NT * i, dr = e >> 9, t = (e >> 3) & 63, sc = (e & 7) * 8;
                *(u32x4*)(P + ((((size_t)dr * BATCH + b) * NH + head) * ML_NLC + ci) * 4096 + t * 64 + sc) = *(const u32x4*)(pt + (dr * 64 + t) * 72 + sc); }
        }
    }
    __syncthreads();
}
constexpr int ML_DENQ = 4;
DEV void ml_den_phase(const Ctx& c) {
    static_assert(ML_NLC % ML_DENQ == 0, "den quarters");
    const bf16_t* Q = (const bf16_t*)(c.ws + WS_MIX + MX_Q); const float* GQ = (const float*)(c.ws + WS_MIX + MX_GQ); const float* DEC = (const float*)(c.ws + WS_MIX + MX_DEC);
    const float* RP = (const float*)(c.ws + WS_MIX + MX_RP); const float* KS = (const float*)(c.ws + WS_MIX + MX_KS); float* DEN = (float*)(c.ws + WS_MIX + MX_DEN);
    float* nst = (float*)c.lds;
    constexpr int EPL = DH / 64;
    for (int u = c.blk; u < BATCH * NH * 2 * ML_DENQ; u += c.nblk) {
        const int qt = u % ML_DENQ, dr = (u / ML_DENQ) & 1, head = (u / (2 * ML_DENQ)) % NH, b = u / (2 * NH * ML_DENQ);
        const size_t cbase = (((size_t)dr * BATCH + b) * NH + head) * ML_NCH;
        __syncthreads();
        for (int d = c.tid; d < DH; d += NT) { float n = 0.f;
#pragma unroll 4
            for (int st = 0; st < ML_NCH; ++st) { const bool isctx = st < ML_NCC; const int ci = isctx ? (dr ? ML_NCC - 1 - st : st) : (dr ? ML_NLC - 1 - (st - ML_NCC) : st - ML_NCC); const int kphys = isctx ? ci : ML_NCC + ci;
                if (!isctx) nst[ci * DH + d] = n;
                n = DEC[cbase + kphys] * n + KS[(cbase + kphys) * DH + d]; } }
        __syncthreads();
        constexpr int ROWS = (ML_NLC / ML_DENQ) * 64;
        const int row0 = NCTX + b * SEQ + qt * ROWS;
#pragma unroll 4
        for (int r = c.wave; r < ROWS; r += NT / 64) { const int row = row0 + r, ci = (qt * ROWS + r) >> 6; const bf16_t* qr = Q + (size_t)row * DI + head * DH + c.lane * EPL; const float* nl = nst + ci * DH + c.lane * EPL; float a = 0.f;
            if (EPL == 8) { const bf16x8 qv = ld8(qr); const f32x4 n0 = *(const f32x4*)nl, n1 = *(const f32x4*)(nl + 4);
#pragma unroll
                for (int q = 0; q < 4; ++q) a += bf2f((bf16_t)qv[q]) * n0[q] + bf2f((bf16_t)qv[4 + q]) * n1[q]; }
            else {
#pragma unroll
                for (int q = 0; q < EPL; ++q) a += bf2f(qr[q]) * nl[q]; }
            a = wave_sum(a);
            if (c.lane == 0) { const size_t lrow = (size_t)(row - NCTX); DEN[((size_t)dr * NLAT + lrow) * NH + head] = RP[((size_t)dr * NLAT + lrow) * NH + head] + GQ[((size_t)dr * NH + head) * NTOK + row] * a; } }
    }
    __syncthreads();
}
constexpr int ML_ES = 64, ML_ET = ML_ES / 16, ML_ETW = ML_ET / 2;
constexpr int ML_NSL = DH / ML_ES;
constexpr int ML_CP = DH * 2 + 16;
constexpr int ML_CBUF = ML_ES * ML_CP, ML_QBUF = 64 * ML_CP;
template <int ABL>
DEV void ml_scan_phase(const Ctx& c) {
    const bf16_t* Q = (const bf16_t*)(c.ws + WS_MIX + MX_Q);
    const bf16_t* VT = (const bf16_t*)(c.ws + WS_MIX + MX_VT);
    const float* GQ = (const float*)(c.ws + WS_MIX + MX_GQ); const float* DEC = (const float*)(c.ws + WS_MIX + MX_DEC);
    const bf16_t* P = (const bf16_t*)(c.ws + WS_MIX + MX_P);
    bf16_t* NUM = (bf16_t*)(c.ws + WS_MIX + MX_NUM); float* DEN = (float*)(c.ws + WS_MIX + MX_NUM);
    unsigned char* ldsC = c.lds; unsigned char* ldsQ = c.lds + ML_CBUF; unsigned char* ldsV = c.lds + ML_CBUF + ML_QBUF;
    const int fr = c.lane & 15, fq = c.lane >> 4, wave = c.wave, tt = wave >> 1, nh2 = wave & 1;
    constexpr int KD = DH / 32, DTW = DH / 16 / 8, QPT = DH / 64;
    const int qrow_t = c.tid >> 3, qcol_t = (c.tid & 7) * 8;
    constexpr int NGRP = BATCH * NH * 2;
    const int XC = (c.nblk % 8 == 0 && NGRP % 8 == 0) ? 8 : 1, xcd = c.blk % XC, lblk = c.blk / XC, W = c.nblk / XC;
    for (int id = lblk; id < (NGRP / XC) * ML_NSL; id += W) {
        const int grp = xcd + XC * (id / ML_NSL), sl = id % ML_NSL, dr = grp & 1, head = (grp >> 1) % NH, b = grp / (2 * NH);
        constexpr bool densl = false;
        const bf16_t* KT = (const bf16_t*)(c.ws + WS_MIX + MX_KTW) + (size_t)dr * NTOK * DI;
        f32x4 cacc[DTW][ML_ET];
#pragma unroll
        for (int n = 0; n < DTW; ++n)
#pragma unroll
            for (int m = 0; m < ML_ET; ++m) cacc[n][m] = (f32x4){0.f, 0.f, 0.f, 0.f};
        const rsrc_t rV = mk_rsrc(VT), rK = mk_rsrc(KT), rP = mk_rsrc(P);
#define SBLD(r, v, s) ((ABL == 3) ? (bf16x8){(short)(v), 1, 2, 3, 4, 5, 6, (short)(s)} : bld(r, v, s))
        const unsigned coff = (unsigned)(fr * ML_CP + 16 * fq);
        __syncthreads();
        for (int i = c.tid; i < ML_CBUF / 4; i += NT) ((unsigned*)ldsC)[i] = 0u;
        {
            const bool c0ctx = ML_NCC > 0; const int ci0 = c0ctx ? (dr ? ML_NCC - 1 : 0) : (dr ? ML_NLC - 1 : 0); const int rc0 = (c0ctx ? b * CTX_LEN : NCTX + b * SEQ) + ci0 * 64;
            const bf16_t* vg = VT + (size_t)rc0 * DI + (size_t)(head * DH + sl * ML_ES) * 64 + (c.tid >> 3) * 64 + (c.tid & 7) * 8;
            if (c.tid < ML_ES * 8) *(u32x4*)(ldsV + (c.tid >> 3) * 144 + (c.tid & 7) * 16) = *(const u32x4*)vg; }
        if (ML_NCC == 0) {
            const int ci0 = dr ? ML_NLC - 1 : 0; const bf16_t* qg = Q + (size_t)(NCTX + b * SEQ + ci0 * 64 + qrow_t) * DI + head * DH + qcol_t;
#pragma unroll
            for (int i = 0; i < QPT; ++i) *(u32x4*)(ldsQ + qrow_t * ML_CP + (qcol_t + 64 * i) * 2) = *(const u32x4*)(qg + 64 * i);
        }
        __syncthreads();
#pragma unroll 1
        for (int st = 0; st < ML_NCH; ++st) {
            const bool isctx = st < ML_NCC; const int ci = isctx ? (dr ? ML_NCC - 1 - st : st) : (dr ? ML_NLC - 1 - (st - ML_NCC) : st - ML_NCC);
            const int L = isctx ? CTX_LEN : SEQ; const int r0 = isctx ? b * CTX_LEN : NCTX + b * SEQ; const int rc = r0 + ci * 64; const int kphys = isctx ? ci : ML_NCC + ci;
            const bool nq = (st + 1 < ML_NCH) && (st + 1 >= ML_NCC);
            const int ncq = (st + 1 == ML_NCC) ? (dr ? ML_NLC - 1 : 0) : (dr ? ci - 1 : ci + 1);
            u32x4 qs[QPT];
            if (nq) { const bf16_t* qg = Q + (size_t)(NCTX + b * SEQ + ncq * 64 + qrow_t) * DI + head * DH + qcol_t;
#pragma unroll
                for (int i = 0; i < QPT; ++i) qs[i] = (ABL == 3) ? (u32x4){(unsigned)i, 1u, 2u, 3u} : *(const u32x4*)(qg + 64 * i); }
            const bool nv = st + 1 < ML_NCH; u32x4 vs = {0u, 0u, 0u, 0u};
            if (nv && c.tid < ML_ES * 8) { const int s1 = st + 1; const bool c1 = s1 < ML_NCC; const int ci1 = c1 ? (dr ? ML_NCC - 1 - s1 : s1) : (dr ? ML_NLC - 1 - (s1 - ML_NCC) : s1 - ML_NCC); const int rc1 = (c1 ? b * CTX_LEN : NCTX + b * SEQ) + ci1 * 64;
                vs = (ABL == 3) ? (u32x4){1u, 2u, 3u, 4u} : *(const u32x4*)(VT + (size_t)rc1 * DI + (size_t)(head * DH + sl * ML_ES) * 64 + (c.tid >> 3) * 64 + (c.tid & 7) * 8); }
            bf16x8 vt[ML_ET][2], kt[DTW][2];
            const unsigned voff = (unsigned)(fr * 144 + 16 * fq);
            const float dec = DEC[(((size_t)dr * BATCH + b) * NH + head) * ML_NCH + kphys];
            const unsigned soff = (unsigned)((fr * 64 + 8 * fq) * 2), tstep = (unsigned)(16 * 64 * 2);
            const unsigned kb = (unsigned)(((size_t)rc * DI + (size_t)(head * DH + wave * DTW * 16) * 64) * 2);
#pragma unroll
            for (int ks = 0; ks < 2; ++ks) {
#pragma unroll
                for (int m = 0; m < ML_ET; ++m) vt[m][ks] = ldo(ldsV + (m * 16) * 144 + ks * 64, voff);
#pragma unroll
                for (int n = 0; n < DTW; ++n) kt[n][ks] = SBLD(rK, soff, kb + n * tstep + ks * 64);
            }
            if (!isctx) {
                const unsigned pb = (unsigned)((((((size_t)dr * BATCH + b) * NH + head) * ML_NLC + ci) * 4096 + (tt * 16) * 64) * 2);
                const unsigned poff = (unsigned)((fr * 64 + 8 * fq) * 2);
                const bf16x8 p0 = SBLD(rP, poff, pb), p1 = SBLD(rP, poff, pb + 64);
                bf16x8 vi[ML_ETW][2];
#pragma unroll
                for (int n = 0; n < ML_ETW; ++n) { const int m = nh2 * ML_ETW + n; vi[n][0] = ldo(ldsV + (m * 16) * 144, voff); vi[n][1] = ldo(ldsV + (m * 16) * 144 + 64, voff); }
                const float gq = GQ[((size_t)dr * NH + head) * NTOK + rc + tt * 16 + fr];
                f32x4 iacc[ML_ETW], oacc[ML_ETW];
#pragma unroll
                for (int n = 0; n < ML_ETW; ++n) { iacc[n] = (f32x4){0.f, 0.f, 0.f, 0.f}; oacc[n] = iacc[n]; }
                const unsigned char* cb0 = ldsC + (nh2 * ML_ETW * 16) * ML_CP; const unsigned char* qb0 = ldsQ + (tt * 16) * ML_CP;
#pragma unroll
                for (int kk = 0; kk < (ABL == 4 ? 1 : KD); ++kk) { const bf16x8 qa = ldo(qb0 + kk * 64, coff);
#pragma unroll
                    for (int n = 0; n < ML_ETW; ++n) iacc[n] = mfma16(ldo(cb0 + (n * 16) * ML_CP + kk * 64, coff), qa, iacc[n]);
                    if ((kk & 3) == 3) SCHED_FENCE(); }
#pragma unroll
                for (int n = 0; n < ML_ETW; ++n) { oacc[n] = mfma16(vi[n][0], p0, oacc[n]); oacc[n] = mfma16(vi[n][1], p1, oacc[n]); }
#pragma unroll
                for (int n = 0; n < ML_ETW; ++n) { const int e0 = (nh2 * ML_ETW + n) * 16 + 4 * fq; const size_t lrow = (size_t)(rc - NCTX + tt * 16 + fr);
                    const f32x4 val = oacc[n] + iacc[n] * gq;
                    u32x2 w; w[0] = pack2(val[0], val[1]); w[1] = pack2(val[2], val[3]);
                    if (ABL > 0) { if (w[0] == 0x12345678u) *(u32x2*)(NUM) = w; }
                    else *(u32x2*)(NUM + ((size_t)dr * NLAT + lrow) * DI + head * DH + sl * ML_ES + e0) = w; }
            }
            if (ABL != 2) __syncthreads();
            if (nq) {
#pragma unroll
                for (int i = 0; i < QPT; ++i) *(u32x4*)(ldsQ + qrow_t * ML_CP + (qcol_t + 64 * i) * 2) = qs[i]; }
            if (nv && c.tid < ML_ES * 8) *(u32x4*)(ldsV + (c.tid >> 3) * 144 + (c.tid & 7) * 16) = vs;
#pragma unroll
            for (int n = 0; n < DTW; ++n)
#pragma unroll
                for (int m = 0; m < ML_ET; ++m) { f32x4 a = cacc[n][m] * dec; a = mfma16(kt[n][0], vt[m][0], a); a = mfma16(kt[n][1], vt[m][1], a); cacc[n][m] = a;
                    u32x2 w; w[0] = pack2(a[0], a[1]); w[1] = pack2(a[2], a[3]);
                    *(u32x2*)(ldsC + (m * 16 + fr) * ML_CP + ((wave * DTW + n) * 16 + 4 * fq) * 2) = w; }
            if (ABL != 2) __syncthreads();
        }
    }
}
#undef SBLD
DEV void ml_finish_phase(const Ctx& c, int mj) {
    const bf16_t* NUM = (const bf16_t*)(c.ws + WS_MIX + MX_NUM); const float* DEN = (const float*)(c.ws + WS_MIX + MX_DEN);
    const bf16_t* XC = (const bf16_t*)(c.ws + WS_MIX + MX_XC); const bf16_t* XMZ = (const bf16_t*)(c.ws + WS_MIX + MX_XMZ); bf16_t* HB2 = (bf16_t*)(c.ws + WS_MIX + MX_HB2);
    const float* og = c.p->in[I_MLONG] + (size_t)mj * DI; const float* sk = c.p->in[I_MLSKIP] + (size_t)mj * DI;
    const int nw = c.nblk * (NT / 64), w0 = c.blk * (NT / 64) + c.wave;
    constexpr int EPL = DH / 64;
    if (EPL == 8) {
        bf16x8 a, b, x, z, an, bn, xn, zn; float e0 = 1.f, e1 = 1.f, e0n = 1.f, e1n = 1.f;
        auto issue = [&](int u, bf16x8& pa, bf16x8& pb, bf16x8& px, bf16x8& pz, float& q0, float& q1) { const int lrow = u / NH, head = u % NH, co = head * DH + c.lane * EPL; const size_t trow = (size_t)(NCTX + lrow);
            pa = ld8(NUM + (size_t)lrow * DI + co); pb = ld8(NUM + ((size_t)NLAT + lrow) * DI + co); px = ld8(XC + trow * DI + co); pz = ld8(XMZ + trow * 2 * DI + DI + co);
            q0 = DEN[(size_t)lrow * NH + head]; q1 = DEN[((size_t)NLAT + lrow) * NH + head]; };
        if (w0 < NLAT * NH) issue(w0, a, b, x, z, e0, e1);
        for (int u = w0; u < NLAT * NH; u += nw) {
            if (u + nw < NLAT * NH) issue(u + nw, an, bn, xn, zn, e0n, e1n);
            const int lrow = u / NH, head = u % NH, co = head * DH + c.lane * EPL;
            const f32x4 g0 = *(const f32x4*)(og + co), g1 = *(const f32x4*)(og + co + 4), s0 = *(const f32x4*)(sk + co), s1 = *(const f32x4*)(sk + co + 4);
            const float i0 = 1.f / fmaxf(fabsf(e0), 1.f), i1 = 1.f / fmaxf(fabsf(e1), 1.f);
            float h[8]; float s = 0.f;
#pragma unroll
            for (int q = 0; q < 8; ++q) { h[q] = bf2f((bf16_t)a[q]) * i0 + bf2f((bf16_t)b[q]) * i1; s += h[q]; }
            const float mu = wave_sum(s) / (float)DH; float vs = 0.f;
#pragma unroll
            for (int q = 0; q < 8; ++q) { h[q] -= mu; vs += h[q] * h[q]; }
            const float rinv = rsqrtf(wave_sum(vs) / (float)DH + EPS);
            float o[8];
#pragma unroll
            for (int q = 0; q < 8; ++q) o[q] = (h[q] * rinv * (q < 4 ? g0[q & 3] : g1[q & 3]) + (q < 4 ? s0[q & 3] : s1[q & 3]) * bf2f((bf16_t)x[q])) * siluf_(bf2f((bf16_t)z[q]));
            u32x4 w; w[0] = pack2(o[0], o[1]); w[1] = pack2(o[2], o[3]); w[2] = pack2(o[4], o[5]); w[3] = pack2(o[6], o[7]); *(u32x4*)(HB2 + (size_t)lrow * DI + co) = w;
            a = an; b = bn; x = xn; z = zn; e0 = e0n; e1 = e1n;
        }
    } else {
        for (int u = w0; u < NLAT * NH; u += nw) {
            const int lrow = u / NH, head = u % NH; const int co = head * DH + c.lane * EPL;
            const float d0 = fmaxf(fabsf(DEN[(size_t)lrow * NH + head]), 1.f), d1 = fmaxf(fabsf(DEN[((size_t)NLAT + lrow) * NH + head]), 1.f);
            const size_t trow = (size_t)(NCTX + lrow);
            float h[EPL]; float s = 0.f;
#pragma unroll
            for (int q = 0; q < EPL; ++q) { h[q] = bf2f(NUM[(size_t)lrow * DI + co + q]) / d0 + bf2f(NUM[((size_t)NLAT + lrow) * DI + co + q]) / d1; s += h[q]; }
            const float mu = wave_sum(s) / (float)DH; float vs = 0.f;
#pragma unroll
            for (int q = 0; q < EPL; ++q) { h[q] -= mu; vs += h[q] * h[q]; }
            const float rinv = rsqrtf(wave_sum(vs) / (float)DH + EPS);
#pragma unroll
            for (int q = 0; q < EPL; ++q) { const float hn = h[q] * rinv * og[co + q]; const float xc = bf2f(XC[trow * DI + co + q]); const float z = bf2f(XMZ[trow * 2 * DI + DI + co + q]);
                HB2[(size_t)lrow * DI + co + q] = f2bf((hn + sk[co + q] * xc) * siluf_(z)); }
        }
    }
}

constexpr int PH_PER_LAYER = 13;
constexpr int N_PHASES = 2 + DEPTH * PH_PER_LAYER + 1;
constexpr bool phase_exists(int ph) {
    if (ph < 2 || ph == N_PHASES - 1) return true;
    const int layer = (ph - 2) / PH_PER_LAYER, s = (ph - 2) % PH_PER_LAYER, kind = layer % 3;
    if (s >= 9) return true;
    return kind == 0 ? s <= 5 : (kind == 1 ? s <= 3 : s <= 8);
}


constexpr bool probe_repeat(int ph) {
    if (PROBE_GROUP == 0) return false;
    if (ph < 2) return PROBE_GROUP == 7 || (PROBE_GROUP == 11 && ph == 1);
    if (ph == N_PHASES - 1) return false;
    const int layer = (ph - 2) / PH_PER_LAYER, s = (ph - 2) % PH_PER_LAYER, kind = layer % 3;
    if (PROBE_GROUP == 1) return s == 11 || s == 12;
    if (PROBE_GROUP == 2) return kind == 1 && s == 1;
    if (PROBE_GROUP == 3) return kind == 2 && (s == 4 || s == 5 || s == 6);
    if (PROBE_GROUP == 4) return kind == 0 && s == 3;
    if (PROBE_GROUP == 33) return kind == 2 && s == 4;
    if (PROBE_GROUP == 34) return kind == 2 && s == 5;
    if (PROBE_GROUP == 35) return kind == 2 && s == 1;
    if (PROBE_GROUP == 36) return kind == 0 && s == 1;
    if (PROBE_GROUP == 21) return kind == 0 && s == 2;
    if (PROBE_GROUP == 22) return kind == 0 && s == 4;
    if (PROBE_GROUP == 23) return kind == 2 && s == 2;
    if (PROBE_GROUP == 24) return kind == 2 && s == 3;
    if (PROBE_GROUP == 25) return kind == 2 && s == 7;
    if (PROBE_GROUP == 26) return s == 10;
    if (PROBE_GROUP == 13) return kind == 2 && (s == 4 || s == 5);
    if (PROBE_GROUP == 14) return kind == 2 && s == 6;
    if (PROBE_GROUP == 12) return (kind == 0 && s == 5) || (kind == 1 && s == 3) || (kind == 2 && s == 8);
    if (PROBE_GROUP == 6) return (kind == 0 && s == 1) || (kind == 2 && s == 1);
    if (PROBE_GROUP == 8) return (kind == 0 && (s == 2 || s == 4)) || (kind == 2 && (s == 2 || s == 3 || s == 7)) || s == 10;
    return false;
}
template <int PH>
DEV void phase_body(Ctx& c) {
    const Params& P = *c.p;
    if constexpr (PH == 0) {
        mods_phase(c);
        transpose_job<0>(c, P.in[I_HYWIN], (bf16_t*)(P.ws + WS_WHYIN), DM, 3 * DM, 2, (size_t)3 * DM * DM, 0);
        transpose_job<0>(c, P.in[I_HYWOUT], (bf16_t*)(P.ws + WS_WHYOUT), DM, DM, 2, (size_t)DM * DM, 0);
        transpose_job<2>(c, P.in[I_S5W1], (bf16_t*)(P.ws + WS_WS5), DM, DM, 1, 0, 0);
        transpose_job<3>(c, P.in[I_S5W2], (bf16_t*)(P.ws + WS_WS5), DM, DM, 1, 0, 0);
        transpose_job<0>(c, P.in[I_MLWUP], (bf16_t*)(P.ws + WS_WMLUP), DM, 2 * DI, 1, 0, 0);
        transpose_job<0>(c, P.in[I_MLWDN], (bf16_t*)(P.ws + WS_WMLDN), DI, DM, 1, 0, 0);
        transpose_job<1>(c, P.in[I_WGU], (bf16_t*)(P.ws + WS_WGU), DM, 2 * FF, 2 * NE, (size_t)2 * FF * DM, 0);
        transpose_job<0>(c, P.in[I_WDN], (bf16_t*)(P.ws + WS_WDN), FF, DM, 2 * NE, (size_t)DM * FF, 0);
        gatew_job(c);
        { float* RWT = (float*)(P.ws + WS_RWT); const float* rw = P.in[I_RW];
          for (int i = c.blk * NT + c.tid; i < DEPTH * NE * DM; i += c.nblk * NT) { const int l = i / (NE * DM), e = (i / DM) % NE, k = i % DM; RWT[i] = rw[((size_t)l * DM + k) * NE + e]; } }
        filter_gen_job(c, 0, 0, SEQ); filter_gen_job(c, 1, 0, CTX_LEN); filter_gen_job(c, 2, 1, SEQ);
#if PROBE_GROUP == 9
        transpose_job<1>(c, P.in[I_WGU], (bf16_t*)(P.ws + WS_WGU), DM, 2 * FF, DEPTH * NE, (size_t)2 * FF * DM, 0);
        transpose_job<0>(c, P.in[I_WDN], (bf16_t*)(P.ws + WS_WDN), FF, DM, DEPTH * NE, (size_t)DM * FF, 0);
#endif
#if PROBE_GROUP == 10
        filter_gen_job(c, 0, 0, SEQ); filter_gen_job(c, 1, 0, CTX_LEN); filter_gen_job(c, 2, 1, SEQ);
        mods_phase(c);
#endif
    } else if constexpr (PH == 1) {
        mods_reduce(c);
        filter_fin_job(c, 0, 0, SEQ); filter_fin_job(c, 1, 0, CTX_LEN); filter_fin_job(c, 2, 1, SEQ);
    } else if constexpr (PH == N_PHASES - 1) {
        final_phase(c);
    } else {
        constexpr int layer = (PH - 2) / PH_PER_LAYER, s = (PH - 2) % PH_PER_LAYER, kind = layer % 3, j = layer / 3;
        constexpr bool ctx_live = layer < 2;
        constexpr int row_lo = (layer == 3) ? NCTX : 0;
        constexpr int out_lo = ctx_live ? 0 : NCTX;
        const float* modbase = (const float*)(P.ws + WS_MOD) + (size_t)layer * NMODR * 6 * DM;
        float* X = (float*)(P.ws + WS_X);
        constexpr int comb = layer > 0 ? layer - 1 : -1;
        if constexpr (s >= 9) {
            if constexpr (s == 9) moe_route_phase(c, layer, out_lo, NTOK);
            else if constexpr (s == 10) moe_scatter_phase(c, layer, out_lo, NTOK);
            else if constexpr (s == 11) moe_gemm1_phase(c, layer);
            else moe_gemm2_phase(c, layer);
        } else if constexpr (kind == 0) {
            constexpr int tile_lo = row_lo / 64, tile_hi = NTOK / 64;
            if constexpr (s == 0) { c.x_from_inputs = (layer == 0); norm1_phase<0>(c, layer, row_lo, NTOK, comb, nullptr); c.x_from_inputs = false; }
            else if constexpr (s == 1) { const bf16_t* W = (const bf16_t*)(P.ws + WS_WHYIN) + (size_t)j * 3 * DM * DM; const float* bi = P.in[I_HYBIN] + (size_t)j * 3 * DM; bf16_t* U = (bf16_t*)(P.ws + WS_MIX + MX_U);
                gemm_dense_phase(c, (const bf16_t*)(P.ws + WS_HB), row_lo, NTOK - row_lo, W, 3 * DM, DM, EpiBf16{U, 3 * DM, bi}); }
            else if constexpr (s == 2) hy_conv_phase(c, j, tile_lo, tile_hi);
            else if constexpr (s == 3) { if constexpr (layer == 0) { hy_longconv_job<SEQ>(c, 0, BATCH); hy_longconv_job<CTX_LEN>(c, 1, 0); } else hy_longconv_job<SEQ>(c, 2, BATCH); }
            else if constexpr (s == 4) hy_gate_phase(c, tile_lo, tile_hi);
            else { const bf16_t* W = (const bf16_t*)(P.ws + WS_WHYOUT) + (size_t)j * DM * DM; const float* bo = P.in[I_HYBOUT] + (size_t)j * DM;
                gemm_dense_phase(c, (const bf16_t*)(P.ws + WS_HB), row_lo, NTOK - row_lo, W, DM, DM, EpiResid{X, bo, modbase, false, c.pscale, layer == 0 ? P.in : nullptr}); }
        } else if constexpr (kind == 1) {
            if constexpr (s == 0) norm1_phase<0>(c, layer, 0, NTOK, comb, nullptr);
            else if constexpr (s == 1) {
                const int busy = S5G * 2 < c.nblk ? S5G * 2 : c.nblk;
                if (c.blk < busy || busy == c.nblk) s5_scan_phase(c);
                if (busy == c.nblk || c.blk >= busy) { const int b2 = busy == c.nblk ? c.blk : c.blk - busy, n2 = busy == c.nblk ? c.nblk : c.nblk - busy;
                    transpose_job<1>(c, P.in[I_WGU] + (size_t)2 * NE * DM * 2 * FF, (bf16_t*)(P.ws + WS_WGU) + (size_t)2 * NE * 2 * FF * DM, DM, 2 * FF, 2 * NE, (size_t)2 * FF * DM, 0, b2, n2);
                    transpose_job<0>(c, P.in[I_WDN] + (size_t)2 * NE * FF * DM, (bf16_t*)(P.ws + WS_WDN) + (size_t)2 * NE * DM * FF, FF, DM, 2 * NE, (size_t)DM * FF, 0, b2, n2); } }
            else if constexpr (s == 2) s5_finish_phase(c, j);
            else { const float* b1 = P.in[I_S5B1] + (size_t)j * DM; const float* b2 = P.in[I_S5B2] + (size_t)j * DM;
                gemm_dense_phase(c, (const bf16_t*)(P.ws + WS_HB), 0, NTOK, (const bf16_t*)(P.ws + WS_WS5), 2 * DM, DM, EpiGlu{X, b1, b2, modbase, c.pscale}); }
        } else {
            if constexpr (s == 0) norm1_phase<2>(c, layer, 0, NTOK, comb, nullptr);
            else if constexpr (s == 1) { bf16_t* XMZ = (bf16_t*)(P.ws + WS_MIX + MX_XMZ);
                gemm_dense_phase(c, (const bf16_t*)(P.ws + WS_HB), 0, NTOK, (const bf16_t*)(P.ws + WS_WMLUP), 2 * DI, DM, EpiBf16{XMZ, 2 * DI, nullptr}); }
            else if constexpr (s == 2) ml_qkv_phase(c, j);
            else if constexpr (s == 3) ml_gates_phase(c, j);
            else if constexpr (s == 4) ml_prep_phase(c);
            else if constexpr (s == 5) ml_den_phase(c);
            else if constexpr (s == 6) { if (c.pscale == 0.f) ml_scan_phase<PROBE_ABL>(c); else ml_scan_phase<0>(c); }
            else if constexpr (s == 7) ml_finish_phase(c, j);
            else gemm_dense_phase(c, (const bf16_t*)(P.ws + WS_MIX + MX_HB2) - (size_t)NCTX * DI, NCTX, NLAT, (const bf16_t*)(P.ws + WS_WMLDN), DM, DI, EpiResid{X, nullptr, modbase, true, c.pscale, nullptr});
        }
    }
}

#ifndef CPU_EMU
#define GRID_SYNC() do { if (fused) xcd_barrier(bar); } while (0)
#else
#define GRID_SYNC() do { } while (0)
#endif
#ifdef DIAG_PHASE
#define PHASE_ON(PH) ((PH) == DIAG_PHASE)
#else
#define PHASE_ON(PH) true
#endif

__global__ void __launch_bounds__(NT, 2) fwd_kernel(Params P) {
#ifdef CPU_EMU
    unsigned char* lds = emu::T.blk->lds;
#else
    extern __shared__ __attribute__((aligned(16))) unsigned char lds[];
#endif
    Ctx c; c.p = &P; c.ws = P.ws; c.lds = (unsigned char*)lds; c.tid = threadIdx.x; c.lane = c.tid & 63; c.wave = UNIFORM(c.tid >> 6); c.nblk = gridDim.x; c.blk = blockIdx.x; c.pscale = 1.f; c.x_from_inputs = false;
#ifndef CPU_EMU
    XcdBarrier bar; bar.bar = nullptr; bar.x = 0; bar.st = nullptr;
    const bool fused = (P.ph_hi - P.ph_lo) > 1;
    if (fused) {
        if (c.tid < 4) ((volatile LAS unsigned*)(lds + LDS_BYTES - 16))[c.tid] = 0u;
        __syncthreads();
        bar = xcd_barrier_post((unsigned*)(P.ws + WS_CTL), (volatile LAS unsigned*)(lds + LDS_BYTES - 16));
    }
#endif
    const int lo = P.ph_lo, hi = P.ph_hi;
#define RUN(PH) if constexpr (phase_exists(PH) && PHASE_ON(PH)) { if (lo <= (PH) && (PH) < hi) { phase_body<PH>(c); if ((PH) + 1 < hi) GRID_SYNC(); \
        if constexpr (probe_repeat(PH)) { c.pscale = 0.f; phase_body<PH>(c); GRID_SYNC(); c.pscale = 1.f; } } }
    RUN(0) RUN(1)
    RUN(2) RUN(3) RUN(4) RUN(5) RUN(6) RUN(7) RUN(8) RUN(9) RUN(10) RUN(11) RUN(12) RUN(13)
    RUN(14) RUN(15) RUN(16) RUN(17) RUN(18) RUN(19) RUN(20) RUN(21) RUN(22) RUN(23) RUN(24) RUN(25)
    RUN(26) RUN(27) RUN(28) RUN(29) RUN(30) RUN(31) RUN(32) RUN(33) RUN(34) RUN(35) RUN(36) RUN(37)
    RUN(38) RUN(39) RUN(40) RUN(41) RUN(42) RUN(43) RUN(44) RUN(45) RUN(46) RUN(47) RUN(48) RUN(49)
    RUN(50) RUN(51) RUN(52) RUN(53) RUN(54)
    static_assert(N_PHASES == 55, "phase list");
#undef RUN
}

extern "C" void kernel_launch(void* const* d_in, const int* in_sizes, int n_in, void* d_out, int out_size, void* d_ws, size_t ws_size, hipStream_t stream) {
    (void)in_sizes; (void)out_size;
    if (n_in != N_IN || ws_size < WS_END) return;
    Params P{};
    for (int i = 0; i < N_IN; ++i) P.in[i] = (const float*)d_in[i];
    P.out = (float*)d_out; P.ws = (unsigned char*)d_ws;
    (void)hipMemsetAsync((char*)d_ws + WS_CTL, 0, CTL_BYTES, stream);
#ifdef CPU_EMU
    int grid = 8; if (getenv("EMU_GRID")) grid = atoi(getenv("EMU_GRID"));
    int plo = 0, phi = N_PHASES; if (getenv("EMU_PH_HI")) phi = atoi(getenv("EMU_PH_HI"));
    for (int ph = plo; ph < phi; ++ph) { Params Q = P; Q.ph_lo = ph; Q.ph_hi = ph + 1; fprintf(stderr, "phase %d\n", ph); emu::run_grid(dim3(grid), dim3(NT), [Q]() { fwd_kernel(Q); }); }
#else
    static int grid = 0;
    if (grid == 0) {
        int dev = 0, cus = 0;
        if (hipGetDevice(&dev) != hipSuccess || hipDeviceGetAttribute(&cus, hipDeviceAttributeMultiprocessorCount, dev) != hipSuccess) { grid = -1; return; }
        if (hipFuncSetAttribute((const void*)fwd_kernel, hipFuncAttributeMaxDynamicSharedMemorySize, LDS_BYTES) != hipSuccess) { grid = -1; return; }
        grid = cus;
    }
    if (grid < 0) return;
#if N_LAUNCH_MODE == 1
    P.ph_lo = 0; P.ph_hi = N_PHASES;
    hipLaunchKernelGGL(fwd_kernel, dim3(grid), dim3(NT), LDS_BYTES, stream, P);
#else
    for (int ph = 0; ph < N_PHASES; ++ph) {
        if (!phase_exists(ph)) continue;
        P.ph_lo = ph; P.ph_hi = ph + 1;
        hipLaunchKernelGGL(fwd_kernel, dim3(grid), dim3(NT), LDS_BYTES, stream, P);
    }
#endif
#endif
}
```

```cpp
#ifdef CPU_EMU
#include "emu.h"
#else
#include <hip/hip_runtime.h>
#endif
#include <stdint.h>
#include <stddef.h>

#ifndef DM
#define DM 1024
#define BATCH 16
#define SEQ 2048
#define GRID_W 64
#define CTX_LEN 256
#endif
#ifndef N_LAUNCH_MODE
#define N_LAUNCH_MODE 1
#endif

#ifndef PROBE_GROUP
#define PROBE_GROUP 0
#endif
#ifndef PROBE_ABL
#define PROBE_ABL 0
#endif
#define DEV __device__ __forceinline__
typedef unsigned short bf16_t;
typedef short bf16x8 __attribute__((ext_vector_type(8)));
typedef float f32x4 __attribute__((ext_vector_type(4)));
typedef float f32x2 __attribute__((ext_vector_type(2)));
typedef unsigned u32x4 __attribute__((ext_vector_type(4)));
typedef unsigned u32x2 __attribute__((ext_vector_type(2)));

constexpr int NE = 32, TOPK = 4, DEPTH = 4;
constexpr int NCTX = BATCH * CTX_LEN, NLAT = BATCH * SEQ, NTOK = NCTX + NLAT;
constexpr int ROWS_G = SEQ / GRID_W;
constexpr int DI = 2 * DM, NH = 4, DH = DI / NH;
constexpr int S5G = DM / 16;
constexpr int NT = 512;
constexpr int NMODR = BATCH + 1;
constexpr int FF = DM;
constexpr int HY_ORDER = 64, HY_EMB = 33;
constexpr float EPS = 1e-6f;
constexpr int MOE_BM = 256;
constexpr int NSLOT = NTOK * TOPK + NE * MOE_BM;

enum { I_X, I_C, I_CTX, I_CCTX, I_ADAW, I_ADAB, I_N1G, I_N2G, I_RW, I_RB, I_WGU, I_BGU, I_WDN, I_BDN,
       I_HYWIN, I_HYBIN, I_HYCW, I_HYCB, I_HYFW1, I_HYFB1, I_HYFW2, I_HYFB2, I_HYFW3, I_HYFREQ, I_HYFBIAS, I_HYWOUT, I_HYBOUT,
       I_S5ARE, I_S5AIM, I_S5LS, I_S5BRE, I_S5BIM, I_S5CRE, I_S5CIM, I_S5D, I_S5W1, I_S5B1, I_S5W2, I_S5B2,
       I_MLWUP, I_MLCW, I_MLCB, I_MLWQ, I_MLWK, I_MLWV, I_MLIGW, I_MLIGB, I_MLFGW, I_MLFGB, I_MLONG, I_MLSKIP, I_MLWDN, I_FNG, N_IN };

constexpr size_t al256(size_t x) { return (x + 255) & ~(size_t)255; }
constexpr size_t WS_CTL = 0;
constexpr size_t CTL_BYTES = 65536;
constexpr size_t CTL_CNT = 16384;
constexpr size_t WS_MOD = WS_CTL + CTL_BYTES;
constexpr size_t WS_X = al256(WS_MOD + (size_t)DEPTH * NMODR * 6 * DM * 4);
constexpr size_t WS_HB = al256(WS_X + (size_t)NTOK * DM * 4);
constexpr size_t WS_WHYIN = al256(WS_HB + (size_t)NTOK * DM * 2);
constexpr size_t WS_WHYOUT = al256(WS_WHYIN + (size_t)2 * 3 * DM * DM * 2);
constexpr size_t WS_WS5 = al256(WS_WHYOUT + (size_t)2 * DM * DM * 2);
constexpr size_t WS_WMLUP = al256(WS_WS5 + (size_t)2 * DM * DM * 2);
constexpr size_t WS_WMLDN = al256(WS_WMLUP + (size_t)2 * DI * DM * 2);
constexpr size_t WS_WGU = al256(WS_WMLDN + (size_t)DM * DI * 2);
constexpr size_t WS_WDN = al256(WS_WGU + (size_t)DEPTH * NE * 2 * FF * DM * 2);
constexpr size_t WS_GW = al256(WS_WDN + (size_t)DEPTH * NE * DM * FF * 2);
constexpr size_t WS_RWT = al256(WS_GW + (size_t)16 * 3 * DI * 2);
constexpr size_t WS_FRAWT = al256(WS_RWT + (size_t)DEPTH * NE * DM * 4);
constexpr size_t WS_FPART = al256(WS_FRAWT + (size_t)3 * 2 * DM * SEQ * 4);
constexpr size_t WS_FR = al256(WS_FPART + (size_t)3 * (SEQ / 8) * 2 * DM * 4);
constexpr size_t WS_TOPE = al256(WS_FR + (size_t)3 * DM * 2 * SEQ * 2);
constexpr size_t WS_TOPG = al256(WS_TOPE + (size_t)NTOK * 4 * 4);
constexpr size_t WS_TOPR = al256(WS_TOPG + (size_t)NTOK * 4 * 4);
constexpr size_t WS_PSLOT = al256(WS_TOPR + (size_t)NTOK * 4 * 4);
constexpr size_t WS_STOK = al256(WS_PSLOT + (size_t)NTOK * 4 * 4);
constexpr size_t WS_SGATE = al256(WS_STOK + (size_t)NSLOT * 4);
constexpr size_t WS_ACT = al256(WS_SGATE + (size_t)NSLOT * 4);
constexpr size_t WS_PO = al256(WS_ACT + (size_t)NSLOT * FF * 2);
constexpr size_t WS_MIX = al256(WS_PO + (size_t)NSLOT * DM * 2);
constexpr size_t MX_U = 0;
constexpr size_t MX_X0 = al256(MX_U + (size_t)NTOK * 3 * DM * 2);
constexpr size_t MX_ZT = al256(MX_X0 + (size_t)NTOK * DM * 2);
constexpr size_t MX_YT = al256(MX_ZT + (size_t)NTOK * DM * 2);
constexpr size_t MX_HY_END = al256(MX_YT + (size_t)NTOK * DM * 2);
constexpr size_t MX_HF = 0;
constexpr size_t MX_YS = al256(MX_HF + (size_t)NTOK * DM * 4);
constexpr size_t MX_S5_END = al256(MX_YS + (size_t)2 * NTOK * DM * 4);
constexpr size_t MX_XMZ = 0;
constexpr size_t MX_Q = al256(MX_XMZ + (size_t)NTOK * 2 * DI * 2);
constexpr size_t MX_K = al256(MX_Q + (size_t)NTOK * DI * 2);
constexpr size_t MX_V = al256(MX_K + (size_t)NTOK * DI * 2);
constexpr size_t MX_XC = al256(MX_V + (size_t)NTOK * DI * 2);
constexpr size_t MX_KT = al256(MX_XC + (size_t)NTOK * DI * 2);
constexpr size_t MX_VT = al256(MX_KT + (size_t)NTOK * DI * 2);
constexpr size_t MX_GATE = al256(MX_VT + (size_t)NTOK * DI * 2);
constexpr size_t MX_NUM = al256(MX_GATE + (size_t)NTOK * 16 * 4);
constexpr size_t MX_DEN = al256(MX_NUM + (size_t)2 * NLAT * DI * 2);
constexpr size_t MX_HB2 = al256(MX_DEN + (size_t)2 * NLAT * NH * 4);
constexpr size_t MX_GQ = al256(MX_HB2 + (size_t)NLAT * DI * 2);
constexpr size_t MX_GWT = al256(MX_GQ + (size_t)2 * NH * NTOK * 4);
constexpr size_t MX_DEC = al256(MX_GWT + (size_t)2 * NH * NTOK * 4);
constexpr size_t MX_P = al256(MX_DEC + (size_t)2 * BATCH * NH * ((CTX_LEN + SEQ) / 64) * 4);
constexpr size_t MX_KTW = al256(MX_P + (size_t)2 * BATCH * NH * (SEQ / 64) * 4096 * 2);
constexpr size_t MX_RP = al256(MX_KTW + (size_t)2 * NTOK * DI * 2);
constexpr size_t MX_KS = al256(MX_RP + (size_t)2 * NLAT * NH * 4);
constexpr size_t MX_ML_END = al256(MX_KS + (size_t)2 * BATCH * NH * ((CTX_LEN + SEQ) / 64) * DH * 4);
constexpr size_t mx3(size_t a, size_t b, size_t c) { return a > b ? (a > c ? a : c) : (b > c ? b : c); }
constexpr size_t WS_END = WS_MIX + mx3(MX_HY_END, MX_S5_END, MX_ML_END);

DEV float bf2f(bf16_t h) { return __builtin_bit_cast(float, (unsigned)h << 16); }
#ifdef CPU_EMU
DEV bf16_t f2bf(float f) { unsigned u = __builtin_bit_cast(unsigned, f); u += 0x7FFFu + ((u >> 16) & 1u); return (bf16_t)(u >> 16); }
DEV unsigned pack2(float a, float b) { return (unsigned)f2bf(a) | ((unsigned)f2bf(b) << 16); }
#else
typedef __bf16 bf16v2_t __attribute__((ext_vector_type(2)));
DEV unsigned pack2(float a, float b) { const f32x2 v = {a, b}; return __builtin_bit_cast(unsigned, __builtin_convertvector(v, bf16v2_t)); }
DEV bf16_t f2bf(float f) { return __builtin_bit_cast(bf16_t, (__bf16)f); }
#endif
#ifdef CPU_EMU
DEV float fexp2_(float x) { return exp2f(x); }
DEV float frcp_(float x) { return 1.f / x; }
#else
DEV float fexp2_(float x) { return __builtin_amdgcn_exp2f(x); }
DEV float frcp_(float x) { return __builtin_amdgcn_rcpf(x); }
#endif
#ifdef CPU_EMU
DEV float fsin_(float x) { return sinf(x); }
DEV float fcos_(float x) { return cosf(x); }
#else
DEV float fsin_(float x) { const float t = x * 0.15915494309189535f; return __builtin_amdgcn_sinf(t - floorf(t)); }
DEV float fcos_(float x) { const float t = x * 0.15915494309189535f; return __builtin_amdgcn_cosf(t - floorf(t)); }
#endif
DEV float sigmoidf_(float x) { return frcp_(1.f + fexp2_(-1.4426950408889634f * x)); }
DEV float siluf_(float x) { return x * sigmoidf_(x); }
#ifdef CPU_EMU
#define DPP_F(v, ctrl) emu_dpp(v, ctrl)
#define DPP_I(v, ctrl) emu_dpp(v, ctrl)
#else
#define DPP_F(v, ctrl) __builtin_bit_cast(float, __builtin_amdgcn_update_dpp(0, __builtin_bit_cast(int, v), ctrl, 0xF, 0xF, false))
#define DPP_I(v, ctrl) __builtin_amdgcn_update_dpp(0, v, ctrl, 0xF, 0xF, false)
#endif
#ifdef CPU_EMU
#define RDLANE_F(v, l) emu_shfl(v, l)
#define RDLANE_I(v, l) emu_shfl(v, l)
#else
#define RDLANE_F(v, l) __builtin_bit_cast(float, __builtin_amdgcn_readlane(__builtin_bit_cast(int, v), l))
#define RDLANE_I(v, l) __builtin_amdgcn_readlane(v, l)
#endif
DEV float wave_sum(float v) {
    v += DPP_F(v, 0xB1); v += DPP_F(v, 0x4E); v += DPP_F(v, 0x141); v += DPP_F(v, 0x140);
    return (RDLANE_F(v, 0) + RDLANE_F(v, 16)) + (RDLANE_F(v, 32) + RDLANE_F(v, 48)); }
DEV f32x4 mfma16(bf16x8 a, bf16x8 b, f32x4 c) {
#ifdef CPU_EMU
    return emu_mfma_16x16x32_bf16(a, b, c);
#else
    return __builtin_amdgcn_mfma_f32_16x16x32_bf16(a, b, c, 0, 0, 0);
#endif
}
#ifdef CPU_EMU
#define UNIFORM(x) (x)
#else
#define UNIFORM(x) __builtin_amdgcn_readfirstlane(x)
#endif
#ifdef CPU_EMU
#define SCHED_FENCE() do { } while (0)
#else
#define SCHED_FENCE() __builtin_amdgcn_sched_barrier(0)
#endif
DEV bf16x8 ld8(const void* p) { return *(const bf16x8*)p; }
#ifdef CPU_EMU
typedef const char* rsrc_t;
DEV rsrc_t mk_rsrc(const void* p) { return (const char*)p; }
DEV bf16x8 bld(rsrc_t r, unsigned voff, unsigned soff) { return *(const bf16x8*)(r + voff + soff); }
#else
typedef __amdgpu_buffer_rsrc_t rsrc_t;
DEV rsrc_t mk_rsrc(const void* p) { return __builtin_amdgcn_make_buffer_rsrc((void*)p, 0, 0xFFFFFFFF, 0x00020000); }
DEV bf16x8 bld(rsrc_t r, unsigned voff, unsigned soff) { return __builtin_bit_cast(bf16x8, __builtin_amdgcn_raw_buffer_load_b128(r, voff, soff, 0)); }
#endif
DEV bf16x8 ldo(const void* ubase, unsigned lane_off) { return *(const bf16x8*)((const char*)ubase + lane_off); }
DEV bf16x8 zero8() { bf16x8 z = {0, 0, 0, 0, 0, 0, 0, 0}; return z; }

struct Params {
    const float* in[N_IN];
    float* out;
    unsigned char* ws;
    int ph_lo, ph_hi;
};
struct Ctx {
    const Params* p; unsigned char* ws; unsigned char* lds; int tid, lane, wave, nblk, blk; float pscale; bool x_from_inputs;
};
DEV const float* mod_ptr(const Ctx& c, int layer, int mrow, int which) { return (const float*)(c.ws + WS_MOD) + (((size_t)layer * NMODR + mrow) * 6 + which) * DM; }
DEV int mod_row_of(int row) { return row < NCTX ? 0 : 1 + (row - NCTX) / SEQ; }

#ifndef CPU_EMU
#define LAS __attribute__((address_space(3)))
#define XB_TMO      128
#define XB_XCNT(j)  (256  + 64 * (j))
#define XB_XSUB(j)  (1280 + 64 * (j))
#define XB_XGEN(j)  (2304 + 64 * (j))
#define XB_TOP      3328
#define XB_TOPGEN   3392
#define XCD_BAR_WORDS 3456
#define XB_SPIN_CAP (1u << 22)
__device__ __forceinline__ unsigned xb_ld(unsigned* p)              { return __hip_atomic_load(p, __ATOMIC_RELAXED, __HIP_MEMORY_SCOPE_AGENT); }
__device__ __forceinline__ unsigned xb_add(unsigned* p, unsigned v) { return __hip_atomic_fetch_add(p, v, __ATOMIC_RELAXED, __HIP_MEMORY_SCOPE_AGENT); }
__device__ __forceinline__ unsigned xb_xcc_id() { return (unsigned)__builtin_amdgcn_s_getreg((3 << 11) | 20) & 0xFu; }
#define XB_SPIN(cond, bar) do { unsigned _sp = 0; while (cond) { __builtin_amdgcn_s_sleep(1); \
    if ((++_sp & 255u) == 0u) { if (xb_ld(&(bar)[XB_TMO])) break; if (_sp > XB_SPIN_CAP) { atomicAdd(&(bar)[XB_TMO], 1u); break; } } } } while (0)
struct XcdBarrier { unsigned* bar; unsigned x; volatile LAS unsigned* st; };
__device__ __forceinline__ XcdBarrier xcd_barrier_post(unsigned* bar, volatile LAS unsigned* st) {
    XcdBarrier b; b.bar = bar; b.x = xb_xcc_id(); b.st = st;
    if (threadIdx.x == 0) (void)xb_add(&bar[XB_XCNT(b.x)], 1u);
    return b;
}
__device__ __forceinline__ void xcd_barrier_complete(unsigned* bar, unsigned x, unsigned& nloc, unsigned& nx) {
    const unsigned G = gridDim.x * gridDim.y * gridDim.z;
    unsigned sum, cnt, mine, sp = 0u;
    for (;;) {
        sum = 0u; cnt = 0u; mine = 0u;
#pragma unroll
        for (unsigned j = 0; j < 16; ++j) { const unsigned c = xb_ld(&bar[XB_XCNT(j)]); sum += c; cnt += (c > 0u) ? 1u : 0u; mine = (j == x) ? c : mine; }
        if (sum == G) break;
        __builtin_amdgcn_s_sleep(1);
        if ((++sp & 255u) == 0u) { if (xb_ld(&bar[XB_TMO])) break; if (sp > XB_SPIN_CAP) { atomicAdd(&bar[XB_TMO], 1u); break; } }
    }
    nloc = mine > 0u ? mine : 1u; nx = cnt > 0u ? cnt : 1u;
}
__device__ __forceinline__ void xcd_barrier(const XcdBarrier& b) {
    asm volatile("s_waitcnt vmcnt(0)" ::: "memory");
    __syncthreads();
    if (threadIdx.x == 0) {
        unsigned* bar = b.bar;
        __builtin_amdgcn_s_waitcnt(0);
        unsigned nloc = b.st[0], nx = b.st[1];
        if (nloc == 0u) { xcd_barrier_complete(bar, b.x, nloc, nx); b.st[0] = nloc; b.st[1] = nx; }
        const unsigned old = xb_add(&bar[XB_XSUB(b.x)], 1u);
        const unsigned gen = old / nloc;
        if (old + 1u == (gen + 1u) * nloc) {
            __builtin_amdgcn_fence(__ATOMIC_RELEASE, "agent");
            asm volatile("s_waitcnt vmcnt(0)" ::: "memory");
            const unsigned og = xb_add(&bar[XB_TOP], 1u);
            const unsigned tg = og / nx;
            if (og + 1u == (tg + 1u) * nx) xb_add(&bar[XB_TOPGEN], 1u);
            else XB_SPIN(xb_ld(&bar[XB_TOPGEN]) == tg, bar);
            __builtin_amdgcn_fence(__ATOMIC_ACQUIRE, "agent");
            xb_add(&bar[XB_XGEN(b.x)], 1u);
            asm volatile("s_waitcnt vmcnt(0)" ::: "memory");
        } else {
            XB_SPIN(xb_ld(&bar[XB_XGEN(b.x)]) == gen, bar);
            __builtin_amdgcn_fence(__ATOMIC_ACQUIRE, "agent");
            asm volatile("s_waitcnt vmcnt(0)" ::: "memory");
        }
    }
    __syncthreads();
}
#endif

constexpr int G_BM = 256, G_BK = 64, G_HALF = 128, G_HTB = G_HALF * G_BK * 2, G_STAGE_BYTES = 8 * G_HTB;
constexpr int LDS_TAB = G_STAGE_BYTES;
constexpr int LDS_BYTES = 152 * 1024;
#ifdef CPU_EMU
#define LAS
DEV void glds16(const void* g, void* l) { memcpy((char*)l + (threadIdx.x & 63) * 16, g, 16); }
#define G_BAR() __syncthreads()
#define G_WAIT_V(n) do { } while (0)
#define G_WAIT_L(n) do { } while (0)
#define G_SETPRIO(x) do { } while (0)
#else
DEV void glds16(const void* g, void* l) { __builtin_amdgcn_global_load_lds((const unsigned*)g, (LAS unsigned*)l, 16, 0, 0); }
#define G_BAR() __builtin_amdgcn_s_barrier()
#define G_WAIT_V(n) asm volatile("s_waitcnt vmcnt(" #n ")" ::: "memory")
#define G_WAIT_L(n) asm volatile("s_waitcnt lgkmcnt(" #n ")" ::: "memory")
#define G_SETPRIO(x) __builtin_amdgcn_s_setprio(x)
#endif
DEV int g_lds_byte(int r, int c) { const int st = (r >> 4) * 2 + (c >> 5), rr = r & 15, cc = c & 31, ob = rr * 64 + cc * 2; return st * 1024 + (ob ^ (((ob >> 9) & 1) << 5)); }
DEV void g_stage_rc(int b, int& R, int& C) { const int st = b / 1024, sb = b % 1024, swz = sb ^ (((sb >> 9) & 1) << 5); R = (st >> 1) * 16 + swz / 64; C = (st & 1) * 32 + (swz % 64) / 2; }
DEV int g_perm32(int rho) { const int n = rho >> 4, i = rho & 15; return 8 * (i >> 2) + 4 * n + (i & 3); }
struct GUnit { unsigned aoff[2][2]; const char* bptr; int m0, n0, aux; };

template <class Sched, class Epi>
DEV void gemm_phase(unsigned char* lds, const bf16_t* Abase, int K, const Sched& S, const Epi& E) {
    const int tid = threadIdx.x, wid = UNIFORM(tid >> 6), lane = tid & 63, wr = wid >> 2, wc = wid & 3, fr = lane & 15, fq = lane >> 4;
    const int nt = K / G_BK;
    unsigned voffB[2];
#pragma unroll
    for (int i = 0; i < 2; ++i) { int R, C; g_stage_rc(tid * 16 + i * 8192, R, C); const int Rb = Epi::PERM ? ((R & ~31) + g_perm32(R & 31)) : R; voffB[i] = (unsigned)(Rb * K + C) * 2u; }
    const size_t kstep = (size_t)(G_BK * 2);
    const size_t hstep = (size_t)G_HALF * K * 2;
    const unsigned ldsw = (unsigned)wid * 1024u;
    const int aoff_l = g_lds_byte(wr * 64 + fr, fq * 8), boff_l = g_lds_byte(wc * 32 + fr, fq * 8);
    const char* Ab = (const char*)Abase;
#define G_SA(b, h) (((b) * 2 + (h)) * G_HTB)
#define G_SB(b, h) ((4 + (b) * 2 + (h)) * G_HTB)
#define G_STAGE_A(bufoff, koff, ao) do { _Pragma("unroll") for (int _i = 0; _i < 2; ++_i) glds16(Ab + (koff) + (ao)[_i], lds + (bufoff) + ldsw + _i * 8192); } while (0)
#define G_STAGE_B(bufoff, gbase) do { _Pragma("unroll") for (int _i = 0; _i < 2; ++_i) glds16((gbase) + voffB[_i], lds + (bufoff) + ldsw + _i * 8192); } while (0)
#define G_LDA(dst, b, h) do { _Pragma("unroll") for (int m = 0; m < 4; ++m) _Pragma("unroll") for (int k = 0; k < 2; ++k) dst[m][k] = *(const bf16x8*)(lds + G_SA(b, h) + aoff_l + m * 2048 + k * 1024); } while (0)
#define G_LDB(dst, b, h) do { _Pragma("unroll") for (int n = 0; n < 2; ++n) _Pragma("unroll") for (int k = 0; k < 2; ++k) dst[n][k] = *(const bf16x8*)(lds + G_SB(b, h) + boff_l + n * 2048 + k * 1024); } while (0)
#define G_MMA(ai, bj, At_, Bt_) do { G_SETPRIO(1); _Pragma("unroll") for (int m = 0; m < 4; ++m) _Pragma("unroll") for (int n = 0; n < 2; ++n) _Pragma("unroll") for (int k = 0; k < 2; ++k) \
        acc[ai][bj][m][n] = mfma16(Bt_[n][k], At_[m][k], acc[ai][bj][m][n]); G_SETPRIO(0); } while (0)
    GUnit cur, nxt; int ui = 0;
    if (!S.next(0, cur)) return;
    f32x4 acc[2][2][4][2];
#pragma unroll
    for (int a = 0; a < 2; ++a)
#pragma unroll
        for (int b = 0; b < 2; ++b)
#pragma unroll
            for (int m = 0; m < 4; ++m)
#pragma unroll
                for (int n = 0; n < 2; ++n) acc[a][b][m][n] = (f32x4){0.f, 0.f, 0.f, 0.f};
    bf16x8 At[4][2], B0[2][2], B1[2][2];
    const char* cB = cur.bptr;
    G_STAGE_B(G_SB(0, 0), cB); G_STAGE_B(G_SB(0, 1), cB + hstep); G_STAGE_A(G_SA(0, 0), 0, cur.aoff[0]); G_STAGE_A(G_SA(0, 1), 0, cur.aoff[1]);
    if (wr == 1) G_BAR();
    G_WAIT_V(2); G_BAR();
    G_STAGE_B(G_SB(1, 0), cB + kstep); G_STAGE_A(G_SA(1, 0), kstep, cur.aoff[0]); G_STAGE_B(G_SB(1, 1), cB + hstep + kstep);
    G_WAIT_V(6); G_BAR();
    for (;;) {
        const bool has_next = S.next(ui + 1, nxt);
        if (!has_next) nxt = cur;
        const char* nB = nxt.bptr;
        for (int t = 0; t < nt; t += 2) {
            const bool last = (t == nt - 2);
            const size_t k1 = (size_t)(t + 1) * kstep;
            const size_t k2 = last ? 0 : (size_t)(t + 2) * kstep, k3 = k2 + kstep;
            const char* b2 = last ? nB : cB + k2; const char* b3 = b2 + kstep;
            unsigned a2o0[2], a2o1[2];
#pragma unroll
            for (int i = 0; i < 2; ++i) { a2o0[i] = last ? nxt.aoff[0][i] : cur.aoff[0][i]; a2o1[i] = last ? nxt.aoff[1][i] : cur.aoff[1][i]; }
            G_LDB(B0, 0, 0); G_LDB(B1, 0, 1); SCHED_FENCE(); G_LDA(At, 0, 0); G_STAGE_A(G_SA(1, 1), k1, cur.aoff[1]);
            G_WAIT_V(8); G_WAIT_L(0); G_BAR(); G_MMA(0, 0, At, B0); G_MMA(0, 1, At, B1); G_BAR(); SCHED_FENCE();
            G_LDA(At, 0, 1); G_STAGE_B(G_SB(0, 0), b2); G_STAGE_B(G_SB(0, 1), b2 + hstep); G_STAGE_A(G_SA(0, 0), k2, a2o0);
            G_WAIT_V(8); G_WAIT_L(0); G_BAR(); G_MMA(1, 0, At, B0); G_MMA(1, 1, At, B1); G_BAR(); SCHED_FENCE();
            G_LDB(B0, 1, 0); G_LDB(B1, 1, 1); SCHED_FENCE(); G_LDA(At, 1, 0); G_STAGE_A(G_SA(0, 1), k2, a2o1);
            G_WAIT_V(8); G_WAIT_L(0); G_BAR(); G_MMA(0, 0, At, B0); G_MMA(0, 1, At, B1); G_BAR(); SCHED_FENCE();
            G_LDA(At, 1, 1); G_STAGE_B(G_SB(1, 0), b3); G_STAGE_B(G_SB(1, 1), b3 + hstep); G_STAGE_A(G_SA(1, 0), k3, a2o0);
            G_WAIT_V(8); G_WAIT_L(0); G_BAR(); G_MMA(1, 0, At, B0); G_MMA(1, 1, At, B1); G_BAR(); SCHED_FENCE();
        }
        if (wr == 0) G_BAR();
        E(acc, cur, wr, wc, fr, fq);
        if (!has_next) break;
#pragma unroll
        for (int a = 0; a < 2; ++a)
#pragma unroll
            for (int b = 0; b < 2; ++b)
#pragma unroll
                for (int m = 0; m < 4; ++m)
#pragma unroll
                    for (int n = 0; n < 2; ++n) acc[a][b][m][n] = (f32x4){0.f, 0.f, 0.f, 0.f};
        cur = nxt; cB = nB; ++ui;
        if (wr == 1) G_BAR();
    }
    G_WAIT_V(0);
    G_BAR();
#undef G_SA
#undef G_SB
#undef G_STAGE_A
#undef G_STAGE_B
#undef G_LDA
#undef G_LDB
#undef G_MMA
}
DEV void g_fill_aoff(GUnit& u, int K, int tid, const int* rowidx  , int m_first) {
#pragma unroll
    for (int i = 0; i < 2; ++i) { int R, C; g_stage_rc(tid * 16 + i * 8192, R, C);
#pragma unroll
        for (int h = 0; h < 2; ++h) { int row; if (rowidx) { row = rowidx[h * G_HALF + R]; row = row < 0 ? 0 : row; } else row = m_first + h * G_HALF + R;
            u.aoff[h][i] = (unsigned)(((size_t)row * K + C) * 2); } }
}
DEV bool xcd_deal(int i, int blk, int nblk, int nM, int nN, int& mt, int& pn) {
    const int XC = (nblk % 8 == 0) ? 8 : 1, x = blk % XC, l = blk / XC, W = nblk / XC;
    const int t0 = (int)(((long)x * nM) / XC), t1 = (int)(((long)(x + 1) * nM) / XC);
    const int id = l + i * W; if (id >= (t1 - t0) * nN) return false;
    mt = t0 + id / nN; pn = id % nN; return true;
}
struct DenseSched {
    int row_lo, nM, nN, K, blk, nblk, tid; const bf16_t* Bt;
    DEV bool next(int i, GUnit& u) const {
        int pm, pn; if (!xcd_deal(i, blk, nblk, nM, nN, pm, pn)) return false;
        u.m0 = row_lo + pm * G_BM; u.n0 = pn * G_BM; u.aux = 0; u.bptr = (const char*)(Bt + (size_t)u.n0 * K);
        g_fill_aoff(u, K, tid, nullptr, u.m0); return true; }
};
template <class Epi>
DEV void gemm_dense_phase(const Ctx& c, const bf16_t* A, int row_lo, int nrows, const bf16_t* Bt, int N, int K, const Epi& E) {
    DenseSched S{row_lo, nrows / G_BM, N / G_BM, K, c.blk, c.nblk, c.tid, Bt};
    gemm_phase(c.lds, A, K, S, E);
}

#define EPI_LOOP_ROWS(ai, m) _Pragma("unroll") for (int ai = 0; ai < 2; ++ai) _Pragma("unroll") for (int m = 0; m < 4; ++m)
#define EPI_LOOP_COLS(bj, n) _Pragma("unroll") for (int bj = 0; bj < 2; ++bj) _Pragma("unroll") for (int n = 0; n < 2; ++n)
struct EpiBf16 {
    static constexpr bool PERM = true;
    bf16_t* O; int ld; const float* bias;
    DEV void operator()(const f32x4 (&acc)[2][2][4][2], const GUnit& u, int wr, int wc, int fr, int fq) const {
        const int row0 = u.m0 + wr * 64 + fr, col0 = u.n0 + wc * 32 + 8 * fq;
        f32x4 bv[2][2];
        EPI_LOOP_COLS(bj, n) bv[bj][n] = bias ? *(const f32x4*)(bias + col0 + bj * G_HALF + 4 * n) : (f32x4){0.f, 0.f, 0.f, 0.f};
        EPI_LOOP_ROWS(ai, m) { bf16_t* rp = O + (size_t)(row0 + ai * G_HALF + m * 16) * ld + col0;
#pragma unroll
            for (int bj = 0; bj < 2; ++bj) { const f32x4 v0 = acc[ai][bj][m][0] + bv[bj][0], v1 = acc[ai][bj][m][1] + bv[bj][1];
                u32x4 w; w[0] = pack2(v0[0], v0[1]); w[1] = pack2(v0[2], v0[3]); w[2] = pack2(v1[0], v1[1]); w[3] = pack2(v1[2], v1[3]); *(u32x4*)(rp + bj * G_HALF) = w; } }
    }
};
struct EpiResid {
    static constexpr bool PERM = false;
    float* X; const float* bias; const float* modbase; bool perm; float ps; const float* const* ins;
    DEV const float* src_row(int row) const { if (!ins) return X + (size_t)row * DM; return row < NCTX ? ins[I_CTX] + (size_t)row * DM : ins[I_X] + (size_t)(row - NCTX) * DM; }
    DEV int orow(int row) const { if (!perm) return row; const int r = row - NCTX, b = r / SEQ, pp = r % SEQ; return NCTX + b * SEQ + (pp % ROWS_G) * GRID_W + pp / ROWS_G; }
    DEV void operator()(const f32x4 (&acc)[2][2][4][2], const GUnit& u, int wr, int wc, int fr, int fq) const {
        const int row0 = u.m0 + wr * 64 + fr, col0 = u.n0 + wc * 32 + 4 * fq;
        f32x4 bv[2][2];
        EPI_LOOP_COLS(bj, n) bv[bj][n] = bias ? *(const f32x4*)(bias + col0 + bj * G_HALF + n * 16) : (f32x4){0.f, 0.f, 0.f, 0.f};
        f32x4 xv[2][2], xn[2][2];
        { const float* xp = src_row(orow(row0)) + col0; EPI_LOOP_COLS(bj, n) xv[bj][n] = *(const f32x4*)(xp + bj * G_HALF + n * 16); }
#pragma unroll
        for (int ai = 0; ai < 2; ++ai) {
            f32x4 mv[2][2];
            EPI_LOOP_COLS(bj, n) mv[bj][n] = *(const f32x4*)(modbase + (size_t)mod_row_of(u.m0 + ai * G_HALF) * 6 * DM + 2 * DM + col0 + bj * G_HALF + n * 16) * ps;
#pragma unroll
            for (int m = 0; m < 4; ++m) {
                const int g = ai * 4 + m;
                if (g < 7) { const int gn = g + 1; const float* xq = src_row(orow(row0 + (gn >> 2) * G_HALF + (gn & 3) * 16)) + col0; EPI_LOOP_COLS(bj, n) xn[bj][n] = *(const f32x4*)(xq + bj * G_HALF + n * 16); }
                float* xp = X + (size_t)orow(row0 + ai * G_HALF + m * 16) * DM + col0;
                EPI_LOOP_COLS(bj, n) *(f32x4*)(xp + bj * G_HALF + n * 16) = xv[bj][n] + mv[bj][n] * (acc[ai][bj][m][n] + bv[bj][n]);
                EPI_LOOP_COLS(bj, n) xv[bj][n] = xn[bj][n];
            }
            SCHED_FENCE();
        }
    }
};
struct EpiGlu {
    static constexpr bool PERM = false;
    float* X; const float* b1; const float* b2; const float* modbase; float ps;
    DEV void operator()(const f32x4 (&acc)[2][2][4][2], const GUnit& u, int wr, int wc, int fr, int fq) const {
        const int row0 = u.m0 + wr * 64 + fr, col0 = (u.n0 + wc * 32 + 4 * fq) / 2;
        f32x2 v1[2][2], v2[2][2], mv[2][2][2];
        EPI_LOOP_COLS(bj, n) { const int co = (bj * G_HALF + n * 16) / 2; v1[bj][n] = *(const f32x2*)(b1 + col0 + co); v2[bj][n] = *(const f32x2*)(b2 + col0 + co);
#pragma unroll
            for (int ai = 0; ai < 2; ++ai) mv[ai][bj][n] = *(const f32x2*)(modbase + (size_t)mod_row_of(u.m0 + ai * G_HALF) * 6 * DM + 2 * DM + col0 + co); }
        f32x2 xv[2][2], xn[2][2];
        { float* xp = X + (size_t)row0 * DM + col0; EPI_LOOP_COLS(bj, n) xv[bj][n] = *(const f32x2*)(xp + (bj * G_HALF + n * 16) / 2); }
        EPI_LOOP_ROWS(ai, m) {
            const int g = ai * 4 + m;
            if (g < 7) { const int gn = g + 1; float* xq = X + (size_t)(row0 + (gn >> 2) * G_HALF + (gn & 3) * 16) * DM + col0; EPI_LOOP_COLS(bj, n) xn[bj][n] = *(const f32x2*)(xq + (bj * G_HALF + n * 16) / 2); }
            float* xp = X + (size_t)(row0 + ai * G_HALF + m * 16) * DM + col0;
            EPI_LOOP_COLS(bj, n) { const f32x4 v = acc[ai][bj][m][n]; f32x2 o = xv[bj][n];
                o[0] += ps * mv[ai][bj][n][0] * (v[0] + v1[bj][n][0]) * sigmoidf_(v[1] + v2[bj][n][0]); o[1] += ps * mv[ai][bj][n][1] * (v[2] + v1[bj][n][1]) * sigmoidf_(v[3] + v2[bj][n][1]);
                *(f32x2*)(xp + (bj * G_HALF + n * 16) / 2) = o; }
            EPI_LOOP_COLS(bj, n) xv[bj][n] = xn[bj][n];
        }
    }
};
struct EpiSwiglu {
    static constexpr bool PERM = true;
    bf16_t* O; const float* bgu_all; float ps;
    DEV void operator()(const f32x4 (&acc)[2][2][4][2], const GUnit& u, int wr, int wc, int fr, int fq) const {
        const float* bgu = bgu_all + (size_t)u.aux * 2 * FF;
        const int row0 = u.m0 + wr * 64 + fr, c0 = u.n0 + wc * 32 + 8 * fq;
        f32x4 bv[2][2];
        EPI_LOOP_COLS(bj, n) bv[bj][n] = *(const f32x4*)(bgu + c0 + bj * G_HALF + 4 * n);
        EPI_LOOP_ROWS(ai, m) { bf16_t* rp = O + (size_t)(row0 + ai * G_HALF + m * 16) * FF + c0 / 2;
#pragma unroll
            for (int bj = 0; bj < 2; ++bj) { float o[4];
#pragma unroll
                for (int n = 0; n < 2; ++n) { const f32x4 v = acc[ai][bj][m][n] + bv[bj][n];
                    const float g0 = fminf(v[0], 7.f), u0 = fminf(fmaxf(v[1], -7.f), 7.f), g1 = fminf(v[2], 7.f), u1 = fminf(fmaxf(v[3], -7.f), 7.f);
                    o[2 * n] = (u0 + 1.f) * g0 * sigmoidf_(1.702f * g0); o[2 * n + 1] = (u1 + 1.f) * g1 * sigmoidf_(1.702f * g1); }
                u32x2 w; w[0] = pack2(o[0], o[1]); w[1] = pack2(o[2], o[3]); *(u32x2*)(rp + bj * (G_HALF / 2)) = w; } }
    }
};
struct EpiMoeDown {
    static constexpr bool PERM = true;
    bf16_t* O; const float* bd_all; const float* sgate; float ps;
    DEV void operator()(const f32x4 (&acc)[2][2][4][2], const GUnit& u, int wr, int wc, int fr, int fq) const {
        const float* bd = bd_all + (size_t)u.aux * DM;
        const int row0 = u.m0 + wr * 64 + fr, col0 = u.n0 + wc * 32 + 8 * fq;
        f32x4 bv[2][2]; float gt[2][4];
        EPI_LOOP_COLS(bj, n) bv[bj][n] = *(const f32x4*)(bd + col0 + bj * G_HALF + 4 * n);
        EPI_LOOP_ROWS(ai, m) gt[ai][m] = sgate[row0 + ai * G_HALF + m * 16];
        EPI_LOOP_ROWS(ai, m) { const int slot = row0 + ai * G_HALF + m * 16; const float g = gt[ai][m]; bf16_t* rp = O + (size_t)slot * DM + col0;
#pragma unroll
            for (int bj = 0; bj < 2; ++bj) { const f32x4 v0 = (acc[ai][bj][m][0] + bv[bj][0]) * g, v1 = (acc[ai][bj][m][1] + bv[bj][1]) * g;
                u32x4 w; w[0] = pack2(v0[0], v0[1]); w[1] = pack2(v0[2], v0[3]); w[2] = pack2(v1[0], v1[1]); w[3] = pack2(v1[2], v1[3]); *(u32x4*)(rp + bj * G_HALF) = w; } }
    }
};

DEV void grid_copy_f4(const Ctx& c, const float* src, float* dst, size_t n) {
    const size_t n4 = n / 4;
    for (size_t i = (size_t)c.blk * NT + c.tid; i < n4; i += (size_t)c.nblk * NT) ((f32x4*)dst)[i] = ((const f32x4*)src)[i];
}
constexpr int MODS_KS = 8, MODS_KL = DM / MODS_KS;
DEV void mods_phase(const Ctx& c) {
    float* sc = (float*)c.lds;
    const float* cc = c.p->in[I_C]; const float* cx = c.p->in[I_CCTX];
    float* PART = (float*)(c.ws + WS_MIX);
    const int ncb = 6 * DM / NT, units = DEPTH * ncb * MODS_KS;
    for (int u = c.blk; u < units; u += c.nblk) {
        const int ks = u % MODS_KS, l = (u / MODS_KS) / ncb, col = ((u / MODS_KS) % ncb) * NT + c.tid, kb = ks * MODS_KL;
        __syncthreads();
        for (int i = c.tid; i < NMODR * MODS_KL; i += NT) { const int r = i / MODS_KL, k = kb + i % MODS_KL; sc[i] = siluf_(r == 0 ? cx[k] : cc[(r - 1) * DM + k]); }
        __syncthreads();
        const float* W = c.p->in[I_ADAW] + (size_t)l * DM * 6 * DM + (size_t)kb * 6 * DM + col;
        float acc[NMODR];
#pragma unroll
        for (int r = 0; r < NMODR; ++r) acc[r] = 0.f;
        for (int k0 = 0; k0 < MODS_KL; k0 += 8) { float w[8];
#pragma unroll
            for (int q = 0; q < 8; ++q) w[q] = W[(size_t)(k0 + q) * 6 * DM];
#pragma unroll
            for (int q = 0; q < 8; ++q)
#pragma unroll
                for (int r = 0; r < NMODR; ++r) acc[r] += sc[r * MODS_KL + k0 + q] * w[q]; }
#pragma unroll
        for (int r = 0; r < NMODR; ++r) PART[(((size_t)ks * DEPTH + l) * NMODR + r) * 6 * DM + col] = acc[r];
    }
    __syncthreads();
}
DEV void mods_reduce(const Ctx& c) {
    const float* PART = (const float*)(c.ws + WS_MIX); float* M = (float*)(c.ws + WS_MOD);
    const size_t n = (size_t)DEPTH * NMODR * 6 * DM;
    for (size_t i = (size_t)c.blk * NT + c.tid; i < n; i += (size_t)c.nblk * NT) { const int col = (int)(i % (6 * DM)), l = (int)(i / ((size_t)NMODR * 6 * DM));
        float a = c.p->in[I_ADAB][(size_t)l * 6 * DM + col];
#pragma unroll
        for (int ks = 0; ks < MODS_KS; ++ks) a += PART[(size_t)ks * n + i];
        M[i] = a; }
}
template <int PERM>
DEV void transpose_job(const Ctx& c, const float* src, bf16_t* dst, int K, int N, int nb, size_t dst_batch_stride, int dst_rows_total, int blk = -1, int nblk = 0) {
    if (blk < 0) { blk = c.blk; nblk = c.nblk; }
    float* tile = (float*)c.lds;
    const int tk = K / 64, tn = N / 256, per = tk * tn, units = per * nb;
    for (int u = blk; u < units; u += nblk) {
        const int b = u / per, r = u % per, k0 = (r / tn) * 64, n0 = (r % tn) * 256;
        const float* S = src + (size_t)b * K * N;
        f32x4 v[8];
#pragma unroll
        for (int i = 0; i < 8; ++i) { const int e = c.tid + NT * i, kk = e >> 6, n4 = (e & 63) * 4; v[i] = __builtin_nontemporal_load((const f32x4*)(S + (size_t)(k0 + kk) * N + n0 + n4)); }
        __syncthreads();
        { const int rot = (c.tid >> 3) & 3;
#pragma unroll
          for (int i = 0; i < 8; ++i) { const int e = c.tid + NT * i, kk = e >> 6, n4 = (e & 63) * 4; const f32x4 w = v[i];
#pragma unroll
            for (int j = 0; j < 4; ++j) { const int jj = (j + rot) & 3; const float x = jj == 0 ? w[0] : jj == 1 ? w[1] : jj == 2 ? w[2] : w[3]; tile[kk * 257 + n4 + jj] = x; } } }
        __syncthreads();
        bf16_t* D = dst + (size_t)b * dst_batch_stride;
#pragma unroll
        for (int i = 0; i < 4; ++i) { const int e = c.tid + NT * i, nn = e >> 3, kc = (e & 7) * 8; const int n = n0 + nn; int np;
            if (PERM < 2) np = n; else np = 2 * n + (PERM - 2);
            u32x4 w;
#pragma unroll
            for (int q = 0; q < 4; ++q) w[q] = pack2(tile[(kc + 2 * q) * 257 + nn], tile[(kc + 2 * q + 1) * 257 + nn]);
            __builtin_nontemporal_store(w, (u32x4*)(D + (size_t)np * K + k0 + kc)); }
    }
    (void)dst_rows_total;
    __syncthreads();
}
DEV void gatew_job(const Ctx& c) {
    bf16_t* GW = (bf16_t*)(c.ws + WS_GW);
    const float sk = sqrtf((float)DH);
    for (size_t i = (size_t)c.blk * NT + c.tid; i < (size_t)16 * 3 * DI; i += (size_t)c.nblk * NT) {
        const int n = (int)(i / (3 * DI)), k = (int)(i % (3 * DI)); const int dr = n >> 3, gate = (n >> 2) & 1, head = n & 3;
        const float* W = gate ? c.p->in[I_MLFGW] : c.p->in[I_MLIGW];
        float v = W[((size_t)dr * 3 * DI + k) * NH + head];
        if (k >= DI && k < 2 * DI) v *= sk;
        GW[i] = f2bf(v);
    }
}
DEV void filter_gen_job(const Ctx& c, int job, int fj, int L) {
    float* zs = (float*)c.lds;
    float* h1 = zs + 8 * 40;
    float* h2 = h1 + 8 * 64;
    const float* w1 = c.p->in[I_HYFW1] + (size_t)fj * HY_EMB * HY_ORDER; const float* b1 = c.p->in[I_HYFB1] + fj * HY_ORDER;
    const float* w2 = c.p->in[I_HYFW2] + (size_t)fj * HY_ORDER * HY_ORDER; const float* b2 = c.p->in[I_HYFB2] + fj * HY_ORDER;
    const float* w3 = c.p->in[I_HYFW3] + (size_t)fj * HY_ORDER * 2 * DM; const float* fq = c.p->in[I_HYFREQ] + fj * HY_ORDER;
    float* FT = (float*)(c.ws + WS_FRAWT) + (size_t)job * 2 * DM * SEQ;
    float* FP = (float*)(c.ws + WS_FPART) + (size_t)job * (SEQ / 8) * 2 * DM;
    const int units = L / 8;
    const float d_lo = logf(0.3f) / 1e-2f, d_hi = logf(1.5f) / 1e-2f;
    for (int u = c.blk; u < units; u += c.nblk) {
        const int t0 = u * 8;
        __syncthreads();
        if (c.tid < 8 * HY_EMB) { const int pp = c.tid / HY_EMB, e = c.tid % HY_EMB, t = t0 + pp; float v;
            const float wt = (6.283185307179586f / (float)L) * (float)t;
            if (e == 0) v = (float)t / (float)(L - 1);
            else { const int bnd = (e - 1) & 15; const float f = 1e-4f + (float)bnd * ((15.f - 1e-4f) / 15.f); v = (e <= 16) ? cosf(f * wt) : -sinf(f * wt); }
            zs[pp * 40 + e] = v; }
        __syncthreads();
        { const int pp = c.tid >> 6, uu = c.tid & 63; float a = b1[uu]; for (int e = 0; e < HY_EMB; ++e) a += zs[pp * 40 + e] * w1[e * HY_ORDER + uu]; h1[pp * 64 + uu] = sinf(fq[uu] * a); }
        __syncthreads();
        { const int pp = c.tid >> 6, uu = c.tid & 63; float a = b2[uu]; for (int k = 0; k < HY_ORDER; ++k) a += h1[pp * 64 + k] * w2[k * HY_ORDER + uu]; h2[pp * 64 + uu] = sinf(fq[uu] * a); }
        __syncthreads();
        for (int col = c.tid; col < 2 * DM; col += NT) {
            float a[8];
#pragma unroll
            for (int pp = 0; pp < 8; ++pp) a[pp] = 0.f;
#pragma unroll 16
            for (int k = 0; k < HY_ORDER; ++k) { const float w = w3[(size_t)k * 2 * DM + col];
#pragma unroll
                for (int pp = 0; pp < 8; ++pp) a[pp] += h2[pp * 64 + k] * w; }
            const int d = col % DM; const float delta = fabsf(d_lo + (d_hi - d_lo) * (float)d / (float)(DM - 1));
            float ps = 0.f;
#pragma unroll
            for (int pp = 0; pp < 8; ++pp) { const int t = t0 + pp; const float tt = (float)t / (float)(L - 1); a[pp] *= expf(-tt * delta); if (!(col >= DM && t == 0)) ps += fabsf(a[pp]); }
            *(f32x4*)(FT + (size_t)col * SEQ + t0) = (f32x4){a[0], a[1], a[2], a[3]};
            *(f32x4*)(FT + (size_t)col * SEQ + t0 + 4) = (f32x4){a[4], a[5], a[6], a[7]};
            FP[(size_t)u * 2 * DM + col] = ps;
        }
    }
    __syncthreads();
}
DEV void filter_fin_job(const Ctx& c, int job, int fj, int L) {
    const float* FT = (const float*)(c.ws + WS_FRAWT) + (size_t)job * 2 * DM * SEQ;
    const float* FP = (const float*)(c.ws + WS_FPART) + (size_t)job * (SEQ / 8) * 2 * DM;
    bf16_t* FR = (bf16_t*)(c.ws + WS_FR) + (size_t)job * DM * 2 * SEQ;
    const float* fb = c.p->in[I_HYFBIAS] + (size_t)fj * DM;
    float* red = (float*)c.lds;
    for (int d = c.blk; d < DM; d += c.nblk) {
        float s = 0.f;
        for (int u = c.tid; u < L / 8; u += NT) s += FP[(size_t)u * 2 * DM + d] + FP[(size_t)u * 2 * DM + DM + d];
        s = wave_sum(s);
        __syncthreads();
        if (c.lane == 0) red[c.wave] = s;
        __syncthreads();
        float tot = 0.f;
#pragma unroll
        for (int w = 0; w < NT / 64; ++w) tot += red[w];
        const float inv = 1.f / tot;
        for (int u = c.tid; u < 2 * L; u += NT) {
            const int idx = (2 * L - u) % (2 * L); float v;
            if (idx < L) v = FT[(size_t)d * SEQ + idx]; else if (idx == L) v = 0.f; else v = FT[(size_t)(DM + d) * SEQ + (2 * L - idx)];
            v *= inv; if (u == 0) v += fb[d];
            FR[(size_t)d * 2 * L + u] = f2bf(v);
        }
    }
    __syncthreads();
}

constexpr int NV = DM / 256;
struct RowVals { f32x4 v[NV]; };
struct RowRaw { f32x4 x[NV]; u32x2 po[4][NV]; };
DEV const float* x_row_src(const Ctx& c, int row) { const char* xr = (const char*)((const float*)(c.ws + WS_X) + (size_t)row * DM); if (!c.x_from_inputs) return (const float*)xr;
    const long d = row < NCTX ? (long)((const char*)c.p->in[I_CTX] - (const char*)(c.ws + WS_X)) : (long)((const char*)c.p->in[I_X] - (const char*)((const float*)(c.ws + WS_X) + (size_t)NCTX * DM)); return (const float*)(xr + d); }
DEV void row_issue(const Ctx& c, RowRaw& rr, int row, bool comb, const int (&ps)[4]) {
    const float* xr = x_row_src(c, row); const bf16_t* PO = (const bf16_t*)(c.ws + WS_PO);
#pragma unroll
    for (int i = 0; i < NV; ++i) rr.x[i] = *(const f32x4*)(xr + 4 * c.lane + 256 * i);
    if (comb) {
#pragma unroll
        for (int k = 0; k < 4; ++k)
#pragma unroll
            for (int i = 0; i < NV; ++i) rr.po[k][i] = __builtin_nontemporal_load((const u32x2*)(PO + (size_t)ps[k] * DM + 4 * c.lane + 256 * i));
    }
}
DEV void ps_issue(const Ctx& c, int (&ps)[4], int row) { const int* p = (const int*)(c.ws + WS_PSLOT) + (size_t)row * 4;
#pragma unroll
    for (int k = 0; k < 4; ++k) ps[k] = p[k]; }
DEV RowVals row_combine(const Ctx& c, const RowRaw& rr, int row, int comb_layer) {
    RowVals r;
#pragma unroll
    for (int i = 0; i < NV; ++i) r.v[i] = rr.x[i];
    if (comb_layer >= 0) {
        const float* m5 = mod_ptr(c, comb_layer, mod_row_of(row), 5); float* X = (float*)(c.ws + WS_X);
#pragma unroll
        for (int i = 0; i < NV; ++i) { f32x4 s = {0.f, 0.f, 0.f, 0.f};
#pragma unroll
            for (int k = 0; k < 4; ++k) { const u32x2 w = rr.po[k][i]; s[0] += bf2f((bf16_t)(w[0] & 0xffff)); s[1] += bf2f((bf16_t)(w[0] >> 16)); s[2] += bf2f((bf16_t)(w[1] & 0xffff)); s[3] += bf2f((bf16_t)(w[1] >> 16)); }
            const f32x4 mm = *(const f32x4*)(m5 + 4 * c.lane + 256 * i); r.v[i] = r.v[i] + mm * s; *(f32x4*)(X + (size_t)row * DM + 4 * c.lane + 256 * i) = r.v[i]; }
    }
    return r;
}
DEV void norm_mod(const Ctx& c, RowVals& r, const float* g, const float* shift, const float* scale) {
    float ss = 0.f;
#pragma unroll
    for (int i = 0; i < NV; ++i) ss += r.v[i][0] * r.v[i][0] + r.v[i][1] * r.v[i][1] + r.v[i][2] * r.v[i][2] + r.v[i][3] * r.v[i][3];
    ss = wave_sum(ss);
    const float rinv = rsqrtf(ss / (float)DM + EPS);
#pragma unroll
    for (int i = 0; i < NV; ++i) { const int o = 4 * c.lane + 256 * i; const f32x4 gg = *(const f32x4*)(g + o);
        f32x4 y = r.v[i] * rinv * gg;
        if (scale) { const f32x4 sc = *(const f32x4*)(scale + o), sh = *(const f32x4*)(shift + o); y = y * (1.f + sc) + sh; }
        r.v[i] = y; }
}
DEV void store_row_bf16(const Ctx& c, bf16_t* dst, const RowVals& r) {
#pragma unroll
    for (int i = 0; i < NV; ++i) { u32x2 w; w[0] = pack2(r.v[i][0], r.v[i][1]); w[1] = pack2(r.v[i][2], r.v[i][3]); *(u32x2*)(dst + 4 * c.lane + 256 * i) = w; }
}
template <class Body>
DEV void row_loop(const Ctx& c, int lo, int hi, int comb_layer, const Body& body) {
    const int nw = c.nblk * (NT / 64), w0 = c.blk * (NT / 64) + c.wave; const bool comb = comb_layer >= 0;
    int row = lo + w0; if (row >= hi) return;
    int ps0[4] = {0, 0, 0, 0}, ps1[4] = {0, 0, 0, 0}; RowRaw cur, nxt;
    if (comb) ps_issue(c, ps0, row);
    row_issue(c, cur, row, comb, ps0);
    if (comb && row + nw < hi) ps_issue(c, ps0, row + nw);
    for (; row < hi; row += nw) {
        const int r1 = row + nw, r2 = row + 2 * nw;
        if (r1 < hi) row_issue(c, nxt, r1, comb, ps0);
        if (comb && r2 < hi) ps_issue(c, ps1, r2);
        RowVals r = row_combine(c, cur, row, comb_layer);
        body(row, r);
        if (r1 < hi) { cur = nxt;
#pragma unroll
            for (int k = 0; k < 4; ++k) ps0[k] = ps1[k]; }
    }
}
template <int OUT>
DEV void norm1_phase(const Ctx& c, int layer, int lo, int hi, int comb_layer, const float* unused) {
    (void)unused;
    const float* g = c.p->in[I_N1G] + (size_t)layer * DM;
    row_loop(c, lo, hi, comb_layer, [&](int row, RowVals& r) {
        const int mr = mod_row_of(row);
        norm_mod(c, r, g, mod_ptr(c, layer, mr, 0), mod_ptr(c, layer, mr, 1));
        int orow = row; if (OUT == 2 && row >= NCTX) { const int rr = row - NCTX, b = rr / SEQ, t = rr % SEQ; orow = NCTX + b * SEQ + (t % GRID_W) * ROWS_G + t / GRID_W; }
        store_row_bf16(c, (bf16_t*)(c.ws + WS_HB) + (size_t)orow * DM, r); });
}
DEV void final_phase(const Ctx& c) {
    row_loop(c, NCTX, NTOK, DEPTH - 1, [&](int row, RowVals& r) {
        norm_mod(c, r, c.p->in[I_FNG], nullptr, nullptr);
        float* o = c.p->out + (size_t)(row - NCTX) * DM;
#pragma unroll
        for (int i = 0; i < NV; ++i) *(f32x4*)(o + 4 * c.lane + 256 * i) = r.v[i]; });
}
struct RouteLane { bool u0, u1, u2, u3, u4; int my_e; float my_bias; int* lcnt; };
DEV void route_finish_row(const Ctx& c, const RouteLane& q, int row, float (&v)[NE], bool valid) {
    const int lane = c.lane; const bool u0 = q.u0, u1 = q.u1, u2 = q.u2, u3 = q.u3, u4 = q.u4; const int my_e = q.my_e; const float my_bias = q.my_bias; int* lcnt = q.lcnt;
#pragma unroll
        for (int i = 0; i < 16; ++i) { const float send = u0 ? v[i] : v[i + 16], keep = u0 ? v[i + 16] : v[i]; v[i] = keep + DPP_F(send, 0xB1); }
#pragma unroll
        for (int i = 0; i < 8; ++i) { const float send = u1 ? v[i] : v[i + 8], keep = u1 ? v[i + 8] : v[i]; v[i] = keep + DPP_F(send, 0x4E); }
#pragma unroll
        for (int i = 0; i < 4; ++i) { const float send = u2 ? v[i] : v[i + 4], keep = u2 ? v[i + 4] : v[i]; v[i] = keep + DPP_F(send, 0x141); }
#pragma unroll
        for (int i = 0; i < 2; ++i) { const float send = u3 ? v[i] : v[i + 2], keep = u3 ? v[i + 2] : v[i]; v[i] = keep + DPP_F(send, 0x140); }
        { const float send = u4 ? v[0] : v[1], keep = u4 ? v[1] : v[0]; v[0] = keep + __shfl_xor(send, 16); }
        float mylg = v[0] + __shfl_xor(v[0], 32) + my_bias;
        int te[4]; float tv[4];
#pragma unroll
        for (int k = 0; k < 4; ++k) { float bv = mylg; int bi = my_e;
#pragma unroll
            for (int st = 0; st < 4; ++st) { float ov; int oi;
                if (st == 0) { ov = DPP_F(bv, 0xB1); oi = DPP_I(bi, 0xB1); } else if (st == 1) { ov = DPP_F(bv, 0x4E); oi = DPP_I(bi, 0x4E); }
                else if (st == 2) { ov = DPP_F(bv, 0x141); oi = DPP_I(bi, 0x141); } else { ov = DPP_F(bv, 0x140); oi = DPP_I(bi, 0x140); }
                const bool take = (ov > bv) || (ov == bv && oi < bi); bv = take ? ov : bv; bi = take ? oi : bi; }
            { const float v0 = RDLANE_F(bv, 0), v1 = RDLANE_F(bv, 16); const int i0 = RDLANE_I(bi, 0), i1 = RDLANE_I(bi, 16);
              const bool take = (v1 > v0) || (v1 == v0 && i1 < i0); bv = take ? v1 : v0; bi = take ? i1 : i0; }
            te[k] = bi; tv[k] = bv; mylg = (my_e == bi) ? -3.0e38f : mylg; }
        const float e1 = expf(tv[1] - tv[0]), e2 = expf(tv[2] - tv[0]), e3 = expf(tv[3] - tv[0]); const float inv = 1.f / (1.f + e1 + e2 + e3);
        if (lane < 4 && valid) { const int k = lane; const int e = k == 0 ? te[0] : k == 1 ? te[1] : k == 2 ? te[2] : te[3]; const float gg = (k == 0 ? 1.f : k == 1 ? e1 : k == 2 ? e2 : e3) * inv;
            const int rank = atomicAdd(&lcnt[e], 1);
            ((int*)(c.ws + WS_TOPE))[(size_t)row * 4 + k] = e; ((float*)(c.ws + WS_TOPG))[(size_t)row * 4 + k] = gg; ((int*)(c.ws + WS_TOPR))[(size_t)row * 4 + k] = rank; }
}
DEV void moe_route_phase(const Ctx& c, int layer, int lo, int hi) {
    float* rwT = (float*)c.lds;
    const float* rwt = (const float*)(c.ws + WS_RWT) + (size_t)layer * NE * DM; const float* rbias = c.p->in[I_RB] + (size_t)layer * NE;
    for (int i = c.tid; i < DM * NE / 4; i += NT) ((f32x4*)rwT)[i] = ((const f32x4*)rwt)[i];
    int* lcnt = (int*)(c.lds + LDS_TAB); int* lbase = lcnt + NE;
    if (c.tid < NE) lcnt[c.tid] = 0;
    int* stok = (int*)(c.ws + WS_STOK);
    for (size_t i = (size_t)c.blk * NT + c.tid; i < (size_t)NSLOT; i += (size_t)c.nblk * NT) stok[i] = -1;
    __syncthreads();
    const float* g = c.p->in[I_N2G] + (size_t)layer * DM;
    int* cnt = (int*)(c.ws + WS_CTL + CTL_CNT) + layer * NE;
    const int lane = c.lane;
    const int b0 = lane & 1, b1 = (lane >> 1) & 1, b2 = (lane >> 2) & 1, b3 = (lane >> 3) & 1, b4 = (lane >> 4) & 1;
    const bool u0 = (b0 ^ b2) != 0, u1 = (b1 ^ b2) != 0, u2 = (b2 ^ b3) != 0, u3 = b3 != 0, u4 = b4 != 0;
    const int my_e = (b0 ^ b2) * 16 + (b1 ^ b2) * 8 + (b2 ^ b3) * 4 + b3 * 2 + b4;
    const float my_bias = rbias[my_e];
    const RouteLane rq{u0, u1, u2, u3, u4, my_e, my_bias, lcnt};
    { const int nw = c.nblk * (NT / 64), w0 = c.blk * (NT / 64) + c.wave; bf16_t* HB = (bf16_t*)(c.ws + WS_HB);
      int row = lo + w0;
      if (row < hi) {
        RowVals xa, xb, na, nb;
        { const float* xr = x_row_src(c, row); const float* xq = x_row_src(c, row + nw < hi ? row + nw : row);
#pragma unroll
          for (int i = 0; i < NV; ++i) { xa.v[i] = *(const f32x4*)(xr + 4 * lane + 256 * i); xb.v[i] = *(const f32x4*)(xq + 4 * lane + 256 * i); } }
        for (; row < hi; row += 2 * nw) {
            const bool hb = row + nw < hi; const int rowb = hb ? row + nw : row; const int r2 = row + 2 * nw, r3 = row + 3 * nw;
            if (r2 < hi) { const float* xr = x_row_src(c, r2); const float* xq = x_row_src(c, r3 < hi ? r3 : r2);
#pragma unroll
                for (int i = 0; i < NV; ++i) { na.v[i] = *(const f32x4*)(xr + 4 * lane + 256 * i); nb.v[i] = *(const f32x4*)(xq + 4 * lane + 256 * i); } }
            RowVals ra = xa, rb = xb;
            { const int mr = mod_row_of(row); norm_mod(c, ra, g, mod_ptr(c, layer, mr, 3), mod_ptr(c, layer, mr, 4)); store_row_bf16(c, HB + (size_t)row * DM, ra); }
            { const int mr = mod_row_of(rowb); norm_mod(c, rb, g, mod_ptr(c, layer, mr, 3), mod_ptr(c, layer, mr, 4)); if (hb) store_row_bf16(c, HB + (size_t)rowb * DM, rb); }
            float va[NE], vb[NE];
#pragma unroll
            for (int e = 0; e < NE; ++e) { float a = 0.f, b = 0.f;
#pragma unroll
                for (int i = 0; i < NV; ++i) { const f32x4 w = *(const f32x4*)(rwT + e * DM + 4 * lane + 256 * i);
                    a += ra.v[i][0] * w[0] + ra.v[i][1] * w[1] + ra.v[i][2] * w[2] + ra.v[i][3] * w[3]; b += rb.v[i][0] * w[0] + rb.v[i][1] * w[1] + rb.v[i][2] * w[2] + rb.v[i][3] * w[3]; }
#ifndef CPU_EMU
                asm volatile("" : "+v"(a), "+v"(b));
#endif
                va[e] = a; vb[e] = b; if ((e & 3) == 3) SCHED_FENCE(); }
            SCHED_FENCE(); route_finish_row(c, rq, row, va, true); SCHED_FENCE();
            route_finish_row(c, rq, rowb, vb, hb);
            SCHED_FENCE();
            if (r2 < hi) { xa = na; xb = nb; }
        } } }
    __syncthreads();
    if (c.tid < NE) lbase[c.tid] = atomicAdd(&cnt[c.tid], lcnt[c.tid]);
    __syncthreads();
    { const int nw = c.nblk * (NT / 64), w0 = c.blk * (NT / 64) + c.wave; const int* te = (const int*)(c.ws + WS_TOPE); int* tr = (int*)(c.ws + WS_TOPR);
      for (int row = lo + w0; row < hi; row += nw) if (c.lane < 4) { const size_t i = (size_t)row * 4 + c.lane; tr[i] = tr[i] + lbase[te[i]]; } }
    __syncthreads();
}
DEV void moe_table(const Ctx& c, int layer) {
    int* tab = (int*)(c.lds + LDS_TAB);
    __syncthreads();
    if (c.tid == 0) { const int* cnt = (const int*)(c.ws + WS_CTL + CTL_CNT) + layer * NE; int a = 0; for (int e = 0; e < NE; ++e) { tab[e] = a; a += (cnt[e] + MOE_BM - 1) / MOE_BM; } tab[NE] = a; }
    __syncthreads();
    for (int mt = c.tid; mt < tab[NE]; mt += NT) { int e = 0; for (int q = 1; q < NE; ++q) e = (tab[q] <= mt) ? q : e; tab[64 + mt] = e; }
    __syncthreads();
}
DEV void moe_scatter_phase(const Ctx& c, int layer, int lo, int hi) {
    moe_table(c, layer);
    const int* tab = (const int*)(c.lds + LDS_TAB);
    const int* te = (const int*)(c.ws + WS_TOPE); const float* tg = (const float*)(c.ws + WS_TOPG); const int* tr = (const int*)(c.ws + WS_TOPR);
    int* ps = (int*)(c.ws + WS_PSLOT); int* stok = (int*)(c.ws + WS_STOK); float* sg = (float*)(c.ws + WS_SGATE);
    for (size_t i = (size_t)lo * 4 + (size_t)c.blk * NT + c.tid; i < (size_t)hi * 4; i += (size_t)c.nblk * NT) {
        const int slot = tab[te[i]] * MOE_BM + tr[i];
        ps[i] = slot; stok[slot] = (int)(i >> 2); sg[slot] = tg[i];
    }
    __syncthreads();
}
DEV int moe_find_expert(const int* tab, int mt) { return tab[64 + mt]; }
constexpr int MOE_LDS_ROWS = LDS_TAB + 4096, MOE_LDS_UNITS = 19;
struct MoeSched {
    const int* tab; const int* rowidx; const int* ldsrows; const bf16_t* W; int nN, Nw, K, blk, nblk, tid;
    DEV bool next(int i, GUnit& u) const {
        int mt, pn; if (!xcd_deal(i, blk, nblk, tab[NE], nN, mt, pn)) return false;
        const int e = moe_find_expert(tab, mt);
        u.m0 = mt * MOE_BM; u.n0 = pn * G_BM; u.aux = e; u.bptr = (const char*)(W + ((size_t)e * Nw + u.n0) * K);
        g_fill_aoff(u, K, tid, ldsrows ? ldsrows + i * 256 : (rowidx ? rowidx + u.m0 : nullptr), u.m0); return true; }
};
DEV void moe_gemm1_phase(const Ctx& c, int layer) {
    moe_table(c, layer);
    const int* tab = (const int*)(c.lds + LDS_TAB);
    const int* stok = (const int*)(c.ws + WS_STOK);
    int* lrows = (int*)(c.lds + MOE_LDS_ROWS);
    const int nN = 2 * FF / G_BM;
    int nun = 0; { int mt, pn; while (nun <= MOE_LDS_UNITS && xcd_deal(nun, c.blk, c.nblk, tab[NE], nN, mt, pn)) ++nun; }
    const bool use_lds = nun <= MOE_LDS_UNITS;
    if (use_lds) { for (int i = 0; i < nun; ++i) { int mt, pn; xcd_deal(i, c.blk, c.nblk, tab[NE], nN, mt, pn); if (c.tid < 256) lrows[i * 256 + c.tid] = stok[mt * MOE_BM + c.tid]; } }
    __syncthreads();
    MoeSched S{tab, stok, use_lds ? lrows : nullptr, (const bf16_t*)(c.ws + WS_WGU) + (size_t)layer * NE * 2 * FF * DM, nN, 2 * FF, DM, c.blk, c.nblk, c.tid};
    EpiSwiglu E{(bf16_t*)(c.ws + WS_ACT), c.p->in[I_BGU] + (size_t)layer * NE * 2 * FF, c.pscale};
    gemm_phase(c.lds, (const bf16_t*)(c.ws + WS_HB), DM, S, E);
}
DEV void moe_gemm2_phase(const Ctx& c, int layer) {
    moe_table(c, layer);
    const int* tab = (const int*)(c.lds + LDS_TAB);
    MoeSched S{tab, nullptr, nullptr, (const bf16_t*)(c.ws + WS_WDN) + (size_t)layer * NE * DM * FF, DM / G_BM, DM, FF, c.blk, c.nblk, c.tid};
    EpiMoeDown E{(bf16_t*)(c.ws + WS_PO), c.p->in[I_BDN] + (size_t)layer * NE * DM, (const float*)(c.ws + WS_SGATE), c.pscale};
    gemm_phase(c.lds, (const bf16_t*)(c.ws + WS_ACT), FF, S, E);
}

DEV int seq_len(int s) { return s < BATCH ? CTX_LEN : SEQ; }
DEV int seq_row0(int s) { return s < BATCH ? s * CTX_LEN : NCTX + (s - BATCH) * SEQ; }
DEV void tile_to_seq(int tt, int& s, int& t0) { if (tt < NCTX / 64) { s = tt / (CTX_LEN / 64); t0 = (tt % (CTX_LEN / 64)) * 64; } else { const int r = tt - NCTX / 64; s = BATCH + r / (SEQ / 64); t0 = (r % (SEQ / 64)) * 64; } }

DEV void hy_conv_phase(const Ctx& c, int hj, int tile_lo, int tile_hi) {
    bf16_t* zt = (bf16_t*)c.lds;
    const bf16_t* U = (const bf16_t*)(c.ws + WS_MIX + MX_U); bf16_t* X0 = (bf16_t*)(c.ws + WS_MIX + MX_X0); bf16_t* ZT = (bf16_t*)(c.ws + WS_MIX + MX_ZT);
    const float* cw = c.p->in[I_HYCW] + (size_t)hj * 3 * 3 * DM; const float* cb = c.p->in[I_HYCB] + (size_t)hj * 3 * DM;
    constexpr int NST = (CTX_LEN % 256 == 0 && SEQ % 256 == 0) ? 4 : ((CTX_LEN % 128 == 0 && SEQ % 128 == 0) ? 2 : 1);
    const int nct = DM / 64, units = ((tile_hi - tile_lo) / NST) * nct;
    const int tl = c.tid >> 3, cg = c.tid & 7;
    for (int u = c.blk; u < units; u += c.nblk) {
        const int c0 = (u % nct) * 64 + cg * 8;
        f32x4 wb[3][2], ww[3][3][2];
#pragma unroll
        for (int gi = 0; gi < 3; ++gi) { const int ch = gi * DM + c0; wb[gi][0] = *(const f32x4*)(cb + ch); wb[gi][1] = *(const f32x4*)(cb + ch + 4);
#pragma unroll
            for (int j = 0; j < 3; ++j) { ww[gi][j][0] = *(const f32x4*)(cw + (size_t)j * 3 * DM + ch); ww[gi][j][1] = *(const f32x4*)(cw + (size_t)j * 3 * DM + ch + 4); } }
        bf16x8 rv[3][3], rn[3][3];
        { int s, t0; tile_to_seq(tile_lo + (u / nct) * NST, s, t0); const int L = seq_len(s), r0 = seq_row0(s), t = t0 + tl;
#pragma unroll
          for (int gi = 0; gi < 3; ++gi)
#pragma unroll
              for (int j = 0; j < 3; ++j) { const int ts = t + j - 1; rv[gi][j] = (ts < 0 || ts >= L) ? zero8() : ld8(U + (size_t)(r0 + ts) * 3 * DM + gi * DM + c0); } }
#pragma unroll 1
        for (int st = 0; st < NST; ++st) {
            int s, t0; tile_to_seq(tile_lo + (u / nct) * NST + st, s, t0);
            const int L = seq_len(s), r0 = seq_row0(s), t = t0 + tl;
            if (st + 1 < NST) { int s2, t2; tile_to_seq(tile_lo + (u / nct) * NST + st + 1, s2, t2); const int L2 = seq_len(s2), r2 = seq_row0(s2), tn = t2 + tl;
#pragma unroll
                for (int gi = 0; gi < 3; ++gi)
#pragma unroll
                    for (int j = 0; j < 3; ++j) { const int ts = tn + j - 1; rn[gi][j] = (ts < 0 || ts >= L2) ? zero8() : ld8(U + (size_t)(r2 + ts) * 3 * DM + gi * DM + c0); } }
            float o[3][8];
#pragma unroll
            for (int gi = 0; gi < 3; ++gi) {
#pragma unroll
                for (int q = 0; q < 4; ++q) { o[gi][q] = wb[gi][0][q]; o[gi][4 + q] = wb[gi][1][q]; }
#pragma unroll
                for (int j = 0; j < 3; ++j) { const bf16x8 v = rv[gi][j];
#pragma unroll
                    for (int q = 0; q < 4; ++q) { o[gi][q] += bf2f((bf16_t)v[q]) * ww[gi][j][0][q]; o[gi][4 + q] += bf2f((bf16_t)v[4 + q]) * ww[gi][j][1][q]; } } }
#pragma unroll
            for (int gi = 0; gi < 3; ++gi)
#pragma unroll
                for (int j = 0; j < 3; ++j) rv[gi][j] = rn[gi][j];
            u32x4 xo; xo[0] = pack2(o[0][0], o[0][1]); xo[1] = pack2(o[0][2], o[0][3]); xo[2] = pack2(o[0][4], o[0][5]); xo[3] = pack2(o[0][6], o[0][7]);
            *(u32x4*)(X0 + (size_t)(r0 + t) * DM + c0) = xo;
            __syncthreads();
#pragma unroll
            for (int q = 0; q < 8; ++q) zt[(cg * 8 + q) * 72 + tl] = f2bf(o[2][q] * o[1][q]);
            __syncthreads();
            { const int ch = c.tid >> 3, tc = (c.tid & 7) * 8;
              *(u32x4*)(ZT + (size_t)r0 * DM + (size_t)((u % nct) * 64 + ch) * L + t0 + tc) = *(const u32x4*)(zt + ch * 72 + tc); }
        }
    }
    __syncthreads();
}
template <int L>
DEV void hy_longconv_job(const Ctx& c, int job, int seq0  ) {
    constexpr int CPITCH = 2 * L * 2 + 32;
    constexpr int MTW = L / 128;
    unsigned char* cp = c.lds;
    const bf16_t* FR = (const bf16_t*)(c.ws + WS_FR) + (size_t)job * DM * 2 * SEQ;
    const bf16_t* ZT = (const bf16_t*)(c.ws + WS_MIX + MX_ZT); bf16_t* YT = (bf16_t*)(c.ws + WS_MIX + MX_YT);
    const int fr = c.lane & 15, fq = c.lane >> 4;
    for (int d = c.blk; d < DM; d += c.nblk) {
        __syncthreads();
        const bf16_t* R = FR + (size_t)d * 2 * L;
        for (int i = c.tid; i < 8 * 2 * L; i += NT) { const int cc = i / (2 * L), idx = i % (2 * L); *(bf16_t*)(cp + cc * CPITCH + idx * 2) = R[(idx - cc + 2 * L) % (2 * L)]; }
        __syncthreads();
        f32x4 acc[MTW];
#pragma unroll
        for (int m = 0; m < MTW; ++m) acc[m] = (f32x4){0.f, 0.f, 0.f, 0.f};
        const bool bval = fr < BATCH;
        const bf16_t* zrow = ZT + (size_t)seq_row0(seq0 + (bval ? fr : 0)) * DM + (size_t)d * L;
        const int a = fr >> 3, cc = fr & 7;
        if constexpr (MTW == 16) {
            auto afrag = [&](int delta) { const int base = (16 * delta + 8 * (fq - a) - c.wave * 256 + 4 * L) % (2 * L); return ld8(cp + cc * CPITCH + base * 2); };
            bf16x8 win[16];
#pragma unroll
            for (int j = 0; j < 16; ++j) win[j] = afrag(-j);
            for (int kt0 = 0; kt0 < L / 32; kt0 += 8) {
#pragma unroll
                for (int kk = 0; kk < 8; ++kk) {
                    const int kt = kt0 + kk;
                    const bf16x8 bfrag = bval ? ld8(zrow + kt * 32 + 8 * fq) : zero8();
#pragma unroll
                    for (int m = 0; m < 16; ++m) acc[m] = mfma16(win[(m - 2 * kk) & 15], bfrag, acc[m]);
                    win[(0 - 2 * (kk + 1)) & 15] = afrag(2 * kt + 2); win[(1 - 2 * (kk + 1)) & 15] = afrag(2 * kt + 1);
                }
            }
        } else {
        for (int kt = 0; kt < L / 32; ++kt) {
            const int s0 = kt * 32;
            const bf16x8 bfrag = bval ? ld8(zrow + s0 + 8 * fq) : zero8();
#pragma unroll
            for (int m = 0; m < MTW; ++m) {
                const int t0 = (c.wave * MTW + m) * 16;
                const int base = (s0 - t0 + 8 * (fq - a) + 2 * L) % (2 * L);
                const bf16x8 afrag = ld8(cp + cc * CPITCH + base * 2);
                acc[m] = mfma16(afrag, bfrag, acc[m]);
            }
        }
        }
        if (bval) {
            bf16_t* yrow = YT + (size_t)seq_row0(seq0 + fr) * DM + (size_t)d * L;
#pragma unroll
            for (int m = 0; m < MTW; ++m) { const int t = (c.wave * MTW + m) * 16 + 4 * fq; u32x2 w; w[0] = pack2(acc[m][0], acc[m][1]); w[1] = pack2(acc[m][2], acc[m][3]); *(u32x2*)(yrow + t) = w; }
        }
    }
    __syncthreads();
}
DEV void hy_gate_phase(const Ctx& c, int tile_lo, int tile_hi) {
    bf16_t* yt = (bf16_t*)c.lds;
    const bf16_t* YT = (const bf16_t*)(c.ws + WS_MIX + MX_YT); const bf16_t* X0 = (const bf16_t*)(c.ws + WS_MIX + MX_X0); bf16_t* HB = (bf16_t*)(c.ws + WS_HB);
    const int nct = DM / 64, units = (tile_hi - tile_lo) * nct;
    u32x4 yv = {0u, 0u, 0u, 0u}, yn = yv; bf16x8 xv = zero8(), xn = xv;
    auto issue = [&](int u, u32x4& py, bf16x8& px) { int s, t0; tile_to_seq(tile_lo + u / nct, s, t0); const int cb0 = (u % nct) * 64; const int L = seq_len(s), r0 = seq_row0(s);
        { const int ch = c.tid >> 3, tc = (c.tid & 7) * 8; py = __builtin_nontemporal_load((const u32x4*)(YT + (size_t)r0 * DM + (size_t)(cb0 + ch) * L + t0 + tc)); }
        { const int tl = c.tid >> 3, cg = c.tid & 7; px = __builtin_nontemporal_load((const bf16x8*)(X0 + (size_t)(r0 + t0 + tl) * DM + cb0 + cg * 8)); } };
    if (c.blk < units) issue(c.blk, yv, xv);
    for (int u = c.blk; u < units; u += c.nblk) {
        int s, t0; tile_to_seq(tile_lo + u / nct, s, t0); const int cb0 = (u % nct) * 64; const int r0 = seq_row0(s);
        if (u + c.nblk < units) issue(u + c.nblk, yn, xn);
        __syncthreads();
        { const int ch = c.tid >> 3, tc = (c.tid & 7) * 8; *(u32x4*)(yt + ch * 72 + tc) = yv; }
        __syncthreads();
        { const int tl = c.tid >> 3, cg = c.tid & 7; float o[8];
#pragma unroll
          for (int q = 0; q < 8; ++q) o[q] = bf2f(yt[(cg * 8 + q) * 72 + tl]) * bf2f((bf16_t)xv[q]);
          u32x4 w; w[0] = pack2(o[0], o[1]); w[1] = pack2(o[2], o[3]); w[2] = pack2(o[4], o[5]); w[3] = pack2(o[6], o[7]);
          *(u32x4*)(HB + (size_t)(r0 + t0 + tl) * DM + cb0 + cg * 8) = w; }
        yv = yn; xv = xn;
    }
    __syncthreads();
}

constexpr int S5_T = 8, S5_NCH = (CTX_LEN + SEQ) / S5_T, S5_SEGC = S5_NCH / 8;
constexpr int S5_OFF_F = 0, S5_OFF_E = 32768, S5_OFF_K = 65536, S5_OFF_LT = S5_OFF_K + 4096, S5_OFF_LS = S5_OFF_LT + 512, S5_OFF_SEG = S5_OFF_LS + 512;
DEV int s5_row(int b, int n, int dr) { return n < CTX_LEN ? b * CTX_LEN + (dr ? CTX_LEN - 1 - n : n) : NCTX + b * SEQ + (dr ? SEQ - 1 - (n - CTX_LEN) : n - CTX_LEN); }
DEV void s5_scan_phase(const Ctx& c) {
    static_assert(S5_NCH % 8 == 0 && CTX_LEN % S5_T == 0, "s5 segments");
    const bf16_t* HB = (const bf16_t*)(c.ws + WS_HB); float* YS = (float*)(c.ws + WS_MIX + MX_YS);
    unsigned char* lds = c.lds;
    bf16_t* Ft = (bf16_t*)(lds + S5_OFF_F); bf16_t* Et = (bf16_t*)(lds + S5_OFF_E); bf16_t* Kt = (bf16_t*)(lds + S5_OFF_K);
    float* lamT = (float*)(lds + S5_OFF_LT); float* lamS = (float*)(lds + S5_OFF_LS); float* seg = (float*)(lds + S5_OFF_SEG);
    float* lamp = seg;
    float* bbar = seg + 1024;
    float* lam1 = seg + 1024 + 2048;
    const int lane = c.lane, wave = c.wave, fr = lane & 15, fq = lane >> 4;
    const int units = S5G * 2;
    for (int u = c.blk; u < units; u += c.nblk) {
        const int dr = u & 1, g = u >> 1;
        __syncthreads();
        if (c.tid < 64) { const int p = c.tid; const size_t gp = ((size_t)dr * S5G + g) * 64 + p;
            const float are = c.p->in[I_S5ARE][gp], aim = c.p->in[I_S5AIM][gp], step = expf(c.p->in[I_S5LS][dr * S5G + g]);
            lam1[2 * p] = are * step; lam1[2 * p + 1] = aim * step;
            const float mag = expf(are * step), lre = mag * fcos_(aim * step), lim = mag * fsin_(aim * step);
            const float nr = lre - 1.f, ni = lim, dn = are * are + aim * aim, f_r = (nr * are + ni * aim) / dn, f_i = (ni * are - nr * aim) / dn;
            for (int h = 0; h < 16; ++h) { const float br = c.p->in[I_S5BRE][gp * 16 + h], bi = c.p->in[I_S5BIM][gp * 16 + h]; bbar[(p * 16 + h) * 2] = f_r * br - f_i * bi; bbar[(p * 16 + h) * 2 + 1] = f_r * bi + f_i * br; }
            for (int t = 0; t < 8; ++t) { const float m = expf(are * step * (float)t); lamp[(t * 64 + p) * 2] = m * fcos_(aim * step * (float)t); lamp[(t * 64 + p) * 2 + 1] = m * fsin_(aim * step * (float)t); }
            { const float m = expf(are * step * (float)S5_T); lamT[2 * p] = m * fcos_(aim * step * (float)S5_T); lamT[2 * p + 1] = m * fsin_(aim * step * (float)S5_T); }
            { const double ang = (double)aim * (double)step * (double)(S5_T * S5_SEGC); const float m = expf(are * step * (float)(S5_T * S5_SEGC)); lamS[2 * p] = m * (float)cos(ang); lamS[2 * p + 1] = m * (float)sin(ang); }
        }
        __syncthreads();
        for (int i = c.tid; i < 8 * 4 * 64 * 8; i += NT) { const int j = i & 7, ln = (i >> 3) & 63, kk = (i >> 9) & 3, m = i >> 11; const int lf = ln & 15, lq = ln >> 4;
            const int p = 16 * (m & 3) + lf, s = 2 * kk + (lq >> 1), hh = 8 * (lq & 1) + j, pw = S5_T - 1 - s;
            const float lr = lamp[(pw * 64 + p) * 2], li = lamp[(pw * 64 + p) * 2 + 1], br = bbar[(p * 16 + hh) * 2], bi = bbar[(p * 16 + hh) * 2 + 1];
            Ft[i] = f2bf(m < 4 ? lr * br - li * bi : lr * bi + li * br); }
        for (int i = c.tid; i < 8 * 4 * 64 * 8; i += NT) { const int j = i & 7, ln = (i >> 3) & 63, kk = (i >> 9) & 3, t = i >> 11; const int lf = ln & 15, lq = ln >> 4;
            const int rho = 32 * kk + 16 * (j >> 2) + 4 * lq + (j & 3), p = rho & 63; const size_t ci = (((size_t)dr * S5G + g) * 16 + lf) * 64 + p;
            const float cr = c.p->in[I_S5CRE][ci], cim = c.p->in[I_S5CIM][ci];
            const float mg = expf(lam1[2 * p] * (float)(t + 1)), lr = mg * fcos_(lam1[2 * p + 1] * (float)(t + 1)), li = mg * fsin_(lam1[2 * p + 1] * (float)(t + 1));
            Et[i] = f2bf(rho < 64 ? cr * lr - cim * li : -(cr * li + cim * lr)); }
        for (int i = c.tid; i < 8 * 256; i += NT) { const int hh = i & 15, h = (i >> 4) & 15, tau = i >> 8; float a = 0.f;
            for (int p = 0; p < 64; ++p) { const size_t ci = (((size_t)dr * S5G + g) * 16 + h) * 64 + p; const float cr = c.p->in[I_S5CRE][ci], cim = c.p->in[I_S5CIM][ci];
                const float lr = lamp[(tau * 64 + p) * 2], li = lamp[(tau * 64 + p) * 2 + 1], br = bbar[(p * 16 + hh) * 2], bi = bbar[(p * 16 + hh) * 2 + 1];
                const float zr = lr * br - li * bi, zi = lr * bi + li * br; a += cr * zr - cim * zi; }
            Kt[i] = f2bf(a); }
        __syncthreads();
        const bool bval = fr < BATCH;
        float ltr[16], lti[16];
#pragma unroll
        for (int m = 0; m < 4; ++m)
#pragma unroll
            for (int jj = 0; jj < 4; ++jj) { const int p = 16 * m + 4 * fq + jj; ltr[m * 4 + jj] = lamT[2 * p]; lti[m * 4 + jj] = lamT[2 * p + 1]; }
        f32x4 xs[8];
#pragma unroll
        for (int m = 0; m < 8; ++m) xs[m] = (f32x4){0.f, 0.f, 0.f, 0.f};
        const int ch0 = wave * S5_SEGC;
#pragma unroll 1
        for (int pass = 0; pass < 2; ++pass) {
            if (pass == 1) {
#pragma unroll
                for (int m = 0; m < 8; ++m) *(f32x4*)(seg + ((wave * 8 + m) * 64 + lane) * 4) = xs[m];
                __syncthreads();
#pragma unroll
                for (int m = 0; m < 8; ++m) xs[m] = (f32x4){0.f, 0.f, 0.f, 0.f};
                for (int v = 0; v < wave; ++v) {
#pragma unroll
                    for (int m = 0; m < 4; ++m) { const f32x4 er = *(const f32x4*)(seg + ((v * 8 + m) * 64 + lane) * 4), ei = *(const f32x4*)(seg + ((v * 8 + m + 4) * 64 + lane) * 4);
#pragma unroll
                        for (int jj = 0; jj < 4; ++jj) { const int p = 16 * m + 4 * fq + jj; const float lr = lamS[2 * p], li = lamS[2 * p + 1]; const float xr = xs[m][jj], xi = xs[m + 4][jj];
                            xs[m][jj] = lr * xr - li * xi + er[jj]; xs[m + 4][jj] = lr * xi + li * xr + ei[jj]; } }
                }
            }
#pragma unroll 1
            for (int cc = 0; cc < S5_SEGC; ++cc) {
                const int n0 = (ch0 + cc) * S5_T;
                bf16x8 uf[4];
#pragma unroll
                for (int kk = 0; kk < 4; ++kk) uf[kk] = bval ? ld8(HB + (size_t)s5_row(fr, n0 + 2 * kk + (fq >> 1), dr) * DM + g * 16 + 8 * (fq & 1)) : zero8();
                if (pass == 1) {
                    bf16x8 xf[4];
#pragma unroll
                    for (int kk = 0; kk < 4; ++kk) { u32x4 w; w[0] = pack2(xs[2 * kk][0], xs[2 * kk][1]); w[1] = pack2(xs[2 * kk][2], xs[2 * kk][3]); w[2] = pack2(xs[2 * kk + 1][0], xs[2 * kk + 1][1]); w[3] = pack2(xs[2 * kk + 1][2], xs[2 * kk + 1][3]); xf[kk] = __builtin_bit_cast(bf16x8, w); }
#pragma unroll
                    for (int t = 0; t < 8; ++t) { f32x4 y = {0.f, 0.f, 0.f, 0.f};
#pragma unroll
                        for (int kk = 0; kk < 4; ++kk) y = mfma16(ld8(Et + ((t * 4 + kk) * 64 + lane) * 8), xf[kk], y);
#pragma unroll
                        for (int kk = 0; kk < 4; ++kk) if (2 * kk <= t) { const int tau = t - 2 * kk - (fq >> 1); const bf16x8 kf = tau >= 0 ? ld8(Kt + (tau * 16 + fr) * 16 + 8 * (fq & 1)) : zero8(); y = mfma16(kf, uf[kk], y); }
                        if (bval) *(f32x4*)(YS + ((size_t)dr * NTOK + s5_row(fr, n0 + t, dr)) * DM + g * 16 + 4 * fq) = y;
                        SCHED_FENCE(); }
                }
#pragma unroll
                for (int m = 0; m < 4; ++m) { f32x4 sr = {0.f, 0.f, 0.f, 0.f}, si = {0.f, 0.f, 0.f, 0.f};
#pragma unroll
                    for (int kk = 0; kk < 4; ++kk) { sr = mfma16(ld8(Ft + ((m * 4 + kk) * 64 + lane) * 8), uf[kk], sr); si = mfma16(ld8(Ft + (((m + 4) * 4 + kk) * 64 + lane) * 8), uf[kk], si); }
#pragma unroll
                    for (int jj = 0; jj < 4; ++jj) { const float lr = ltr[m * 4 + jj], li = lti[m * 4 + jj]; const float xr = xs[m][jj], xi = xs[m + 4][jj];
                        xs[m][jj] = lr * xr - li * xi + sr[jj]; xs[m + 4][jj] = lr * xi + li * xr + si[jj]; }
                    SCHED_FENCE(); }
            }
        }
    }
    __syncthreads();
}
DEV void s5_finish_phase(const Ctx& c, int s5j) {
    const float* YS = (const float*)(c.ws + WS_MIX + MX_YS); bf16_t* HB = (bf16_t*)(c.ws + WS_HB);
    const float* dsk = c.p->in[I_S5D] + (size_t)s5j * DM;
    const size_t n4 = (size_t)NTOK * DM / 4;
    for (size_t i = (size_t)c.blk * NT + c.tid; i < n4; i += (size_t)c.nblk * NT) {
        const u32x2 hw = ((const u32x2*)HB)[i]; const float h[4] = {bf2f((bf16_t)(hw[0] & 0xffff)), bf2f((bf16_t)(hw[0] >> 16)), bf2f((bf16_t)(hw[1] & 0xffff)), bf2f((bf16_t)(hw[1] >> 16))};
        const f32x4 a = __builtin_nontemporal_load((const f32x4*)YS + i), b = __builtin_nontemporal_load((const f32x4*)(YS + (size_t)NTOK * DM) + i);        const f32x4 dd = *(const f32x4*)(dsk + (i * 4) % DM);
        float o[4];
#pragma unroll
        for (int q = 0; q < 4; ++q) { const float x = a[q] + b[q] + dd[q] * h[q]; o[q] = 0.5f * x * (1.f + tanhf(0.7978845608028654f * (x + 0.044715f * x * x * x))); }
        u32x2 w; w[0] = pack2(o[0], o[1]); w[1] = pack2(o[2], o[3]); ((u32x2*)HB)[i] = w;
    }
}

DEV void ml_qkv_phase(const Ctx& c, int mj) {
    bf16_t* kt = (bf16_t*)c.lds; bf16_t* vt = kt + 64 * 72;
    const bf16_t* XMZ = (const bf16_t*)(c.ws + WS_MIX + MX_XMZ);
    bf16_t* Q = (bf16_t*)(c.ws + WS_MIX + MX_Q); bf16_t* Kb = (bf16_t*)(c.ws + WS_MIX + MX_K); bf16_t* V = (bf16_t*)(c.ws + WS_MIX + MX_V); bf16_t* XC = (bf16_t*)(c.ws + WS_MIX + MX_XC);
    bf16_t* KT = (bf16_t*)(c.ws + WS_MIX + MX_KT); bf16_t* VT = (bf16_t*)(c.ws + WS_MIX + MX_VT);
    const float* cw = c.p->in[I_MLCW] + (size_t)mj * 3 * DI; const float* cb = c.p->in[I_MLCB] + (size_t)mj * DI;
    const float* wq = c.p->in[I_MLWQ] + (size_t)mj * DI * 4; const float* wk = c.p->in[I_MLWK] + (size_t)mj * DI * 4; const float* wv = c.p->in[I_MLWV] + (size_t)mj * DI * 4;
    const float kscale = 1.f / sqrtf((float)DH);
    constexpr int NST = (CTX_LEN % 256 == 0 && SEQ % 256 == 0) ? 4 : ((CTX_LEN % 128 == 0 && SEQ % 128 == 0) ? 2 : 1);
    const int nct = DI / 64, units = (NTOK / (64 * NST)) * nct;
    const int tl = c.tid >> 3, cg = c.tid & 7;
    for (int u = c.blk; u < units; u += c.nblk) {
        const int cb0 = (u % nct) * 64, c0 = cb0 + cg * 8;
        f32x4 wc0[3], wc1[3], mq[2][4], mk[2][4], mv[2][4];
        const f32x4 b0 = *(const f32x4*)(cb + c0), b1 = *(const f32x4*)(cb + c0 + 4);
#pragma unroll
        for (int j = 0; j < 3; ++j) { wc0[j] = *(const f32x4*)(cw + (size_t)j * DI + c0); wc1[j] = *(const f32x4*)(cw + (size_t)j * DI + c0 + 4); }
#pragma unroll
        for (int blk = 0; blk < 2; ++blk) { const size_t wb = (size_t)((c0 >> 2) + blk) * 16;
#pragma unroll
            for (int i = 0; i < 4; ++i) { mq[blk][i] = *(const f32x4*)(wq + wb + i * 4); mk[blk][i] = *(const f32x4*)(wk + wb + i * 4); mv[blk][i] = *(const f32x4*)(wv + wb + i * 4); } }
        bf16x8 rv[3], rn[3];
        { int s, t0; tile_to_seq((u / nct) * NST, s, t0); const int L = seq_len(s), r0 = seq_row0(s), t = t0 + tl;
#pragma unroll
          for (int j = 0; j < 3; ++j) { const int ts = t + j - 1; rv[j] = (ts < 0 || ts >= L) ? zero8() : ld8(XMZ + (size_t)(r0 + ts) * 2 * DI + c0); } }
#pragma unroll 1
        for (int st = 0; st < NST; ++st) {
            int s, t0; tile_to_seq((u / nct) * NST + st, s, t0); const int r0 = seq_row0(s), t = t0 + tl;
            if (st + 1 < NST) { int s2, t2; tile_to_seq((u / nct) * NST + st + 1, s2, t2); const int L2 = seq_len(s2), r2 = seq_row0(s2), tn = t2 + tl;
#pragma unroll
                for (int j = 0; j < 3; ++j) { const int ts = tn + j - 1; rn[j] = (ts < 0 || ts >= L2) ? zero8() : ld8(XMZ + (size_t)(r2 + ts) * 2 * DI + c0); } }
            float xm[8], xc[8];
#pragma unroll
            for (int q = 0; q < 4; ++q) { xc[q] = b0[q]; xc[4 + q] = b1[q]; }
#pragma unroll
            for (int j = 0; j < 3; ++j) { const bf16x8 v = rv[j];
#pragma unroll
                for (int q = 0; q < 8; ++q) { const float f = bf2f((bf16_t)v[q]); xc[q] += f * (q < 4 ? wc0[j][q & 3] : wc1[j][q & 3]); if (j == 1) xm[q] = f; } }
#pragma unroll
            for (int j = 0; j < 3; ++j) rv[j] = rn[j];
#pragma unroll
            for (int q = 0; q < 8; ++q) xc[q] = siluf_(xc[q]);
            float qo[8], ko[8], vo[8];
#pragma unroll
            for (int blk = 0; blk < 2; ++blk)
#pragma unroll
                for (int o = 0; o < 4; ++o) { float aq = 0.f, ak = 0.f, av = 0.f;
#pragma unroll
                    for (int i = 0; i < 4; ++i) { aq += xc[blk * 4 + i] * mq[blk][i][o]; ak += xc[blk * 4 + i] * mk[blk][i][o]; av += xm[blk * 4 + i] * mv[blk][i][o]; }
                    qo[blk * 4 + o] = aq; ko[blk * 4 + o] = ak * kscale; vo[blk * 4 + o] = av; }
            const size_t ro = (size_t)(r0 + t) * DI + c0; u32x4 w;
            w[0] = pack2(qo[0], qo[1]); w[1] = pack2(qo[2], qo[3]); w[2] = pack2(qo[4], qo[5]); w[3] = pack2(qo[6], qo[7]); *(u32x4*)(Q + ro) = w;
            w[0] = pack2(ko[0], ko[1]); w[1] = pack2(ko[2], ko[3]); w[2] = pack2(ko[4], ko[5]); w[3] = pack2(ko[6], ko[7]); *(u32x4*)(Kb + ro) = w;
            w[0] = pack2(vo[0], vo[1]); w[1] = pack2(vo[2], vo[3]); w[2] = pack2(vo[4], vo[5]); w[3] = pack2(vo[6], vo[7]); *(u32x4*)(V + ro) = w;
            w[0] = pack2(xc[0], xc[1]); w[1] = pack2(xc[2], xc[3]); w[2] = pack2(xc[4], xc[5]); w[3] = pack2(xc[6], xc[7]); *(u32x4*)(XC + ro) = w;
            __syncthreads();
#pragma unroll
            for (int q = 0; q < 8; ++q) { kt[(cg * 8 + q) * 72 + tl] = f2bf(ko[q]); vt[(cg * 8 + q) * 72 + tl] = f2bf(vo[q]); }
            __syncthreads();
            { const int ch = c.tid >> 3, tc = (c.tid & 7) * 8; const size_t o = (size_t)(r0 + t0) * DI + (size_t)(cb0 + ch) * 64 + tc;
              *(u32x4*)(KT + o) = *(const u32x4*)(kt + ch * 72 + tc); *(u32x4*)(VT + o) = *(const u32x4*)(vt + ch * 72 + tc); }
        }
    }
    __syncthreads();
}
DEV void ml_gates_phase(const Ctx& c, int mj) {
    const bf16_t* Q = (const bf16_t*)(c.ws + WS_MIX + MX_Q); const bf16_t* Kb = (const bf16_t*)(c.ws + WS_MIX + MX_K); const bf16_t* V = (const bf16_t*)(c.ws + WS_MIX + MX_V);
    const bf16_t* GW = (const bf16_t*)(c.ws + WS_GW); float* GATE = (float*)(c.ws + WS_MIX + MX_GATE);
    const int fr = c.lane & 15, fq = c.lane >> 4;
    const int dr = fr >> 3, gate = (fr >> 2) & 1, head = fr & 3;
    const float bias = (gate ? c.p->in[I_MLFGB] : c.p->in[I_MLIGB])[((size_t)mj * 2 + dr) * NH + head];
    constexpr int NSTEP = 3 * DI / 32, SPW = NSTEP / 8, SPP = DI / 32;
    static_assert(NSTEP % 8 == 0, "gate k-steps per wave");
    f32x4* red = (f32x4*)c.lds;
    for (int u = c.blk; u < NTOK / 16; u += c.nblk) {
        f32x4 acc = {0.f, 0.f, 0.f, 0.f};
        const size_t ro = (size_t)(u * 16 + fr) * DI;
#pragma unroll
        for (int i = 0; i < SPW; ++i) { const int s = c.wave * SPW + i, part = s / SPP, k = (s % SPP) * 32;
            const bf16_t* A = (part == 0 ? Q : part == 1 ? Kb : V) + ro + k + 8 * fq; const bf16_t* B = GW + (size_t)fr * 3 * DI + part * DI + k + 8 * fq;
            acc = mfma16(ld8(A), ld8(B), acc); }
        __syncthreads();
        red[c.wave * 64 + c.lane] = acc;
        __syncthreads();
        if (c.wave == 0) { f32x4 s = red[c.lane];
#pragma unroll
            for (int w = 1; w < 8; ++w) s = s + red[w * 64 + c.lane];
#pragma unroll
            for (int j = 0; j < 4; ++j) GATE[(size_t)(u * 16 + 4 * fq + j) * 16 + fr] = s[j] + bias; }
    }
    __syncthreads();
}
constexpr int ML_NCC = CTX_LEN / 64, ML_NLC = SEQ / 64, ML_NCH = ML_NCC + ML_NLC;
DEV void ml_prep_phase(const Ctx& c) {
    const bf16_t* Q = (const bf16_t*)(c.ws + WS_MIX + MX_Q); const bf16_t* Kb = (const bf16_t*)(c.ws + WS_MIX + MX_K);
    const float* GATE = (const float*)(c.ws + WS_MIX + MX_GATE);
    float* GQ = (float*)(c.ws + WS_MIX + MX_GQ); float* GWT = (float*)(c.ws + WS_MIX + MX_GWT); float* DEC = (float*)(c.ws + WS_MIX + MX_DEC); bf16_t* P = (bf16_t*)(c.ws + WS_MIX + MX_P);
    float* gG = (float*)c.lds; float* gI = gG + 128; bf16_t* pt = (bf16_t*)(c.lds + 1024); float* rsum = (float*)(c.lds + 1024 + 2 * 64 * 72 * 2);
    constexpr int ML_PP = DH * 2 + 16; unsigned char* ldsQK = c.lds + 21760;
    const int fr = c.lane & 15, fq = c.lane >> 4, wave = c.wave, tt = wave >> 1, nh2 = wave & 1;
    constexpr int KD = DH / 32;
    const int units = BATCH * NH * ML_NCH;
    for (int u = c.blk; u < units; u += c.nblk) {
        const int k = u % ML_NCH, head = (u / ML_NCH) % NH, b = u / (ML_NCH * NH);
        const bool isctx = k < ML_NCC; const int ci = isctx ? k : k - ML_NCC; const int r0 = isctx ? b * CTX_LEN : NCTX + b * SEQ; const int rc = r0 + ci * 64;
        __syncthreads();
        constexpr int QPT = DH / 64;
        const bf16_t* KTs = (const bf16_t*)(c.ws + WS_MIX + MX_KT); bf16_t* KTW = (bf16_t*)(c.ws + WS_MIX + MX_KTW);
        const int sc = (c.tid & 7) * 8;
        bf16x8 kvr[QPT]; u32x4 qreg[QPT], kreg[QPT];
#pragma unroll
        for (int i = 0; i < QPT; ++i) kvr[i] = ld8(KTs + (size_t)rc * DI + (size_t)(head * DH + (c.tid >> 3) + 64 * i) * 64 + sc);
        if (!isctx) { const int r = c.tid >> 3, cl = (c.tid & 7) * 8; const bf16_t* qg = Q + (size_t)(rc + r) * DI + head * DH + cl; const bf16_t* kg = Kb + (size_t)(rc + r) * DI + head * DH + cl;
#pragma unroll
            for (int i = 0; i < QPT; ++i) { qreg[i] = *(const u32x4*)(qg + 64 * i); kreg[i] = *(const u32x4*)(kg + 64 * i); } }
        if (wave < 2) {
            const int dr = wave, r = c.lane; const float fg = GATE[(size_t)(rc + r) * 16 + dr * 8 + 4 + head], ig = GATE[(size_t)(rc + r) * 16 + dr * 8 + head];
            const float lf = fminf(fg, 0.f) - log1pf(expf(-fabsf(fg)));
            float cum = lf;
#pragma unroll
            for (int o = 1; o < 64; o <<= 1) { const float nb = dr ? __shfl_down(cum, o) : __shfl_up(cum, o); const bool ok = dr ? (r + o < 64) : (r - o >= 0); cum += ok ? nb : 0.f; }
            const float tot = __shfl(cum, dr ? 0 : 63);
            gG[dr * 64 + r] = cum; gI[dr * 64 + r] = ig;
            GQ[((size_t)dr * NH + head) * NTOK + rc + r] = expf(cum); GWT[((size_t)dr * NH + head) * NTOK + rc + r] = expf(tot - cum + ig);
            if (r == 0) DEC[(((size_t)dr * BATCH + b) * NH + head) * ML_NCH + k] = expf(tot);
        }
        if (!isctx) { const int r = c.tid >> 3, cl = (c.tid & 7) * 8;
#pragma unroll
            for (int i = 0; i < QPT; ++i) { *(u32x4*)(ldsQK + r * ML_PP + (cl + 64 * i) * 2) = qreg[i]; *(u32x4*)(ldsQK + 64 * ML_PP + r * ML_PP + (cl + 64 * i) * 2) = kreg[i]; } }
        __syncthreads();
        {
            float w0[8], w1[8];
#pragma unroll
            for (int q = 0; q < 8; ++q) { w0[q] = expf(gG[63] - gG[sc + q] + gI[sc + q]); w1[q] = expf(gG[64] - gG[64 + sc + q] + gI[64 + sc + q]); }
#pragma unroll
            for (int i = 0; i < QPT; ++i) { const int d = (c.tid >> 3) + 64 * i; const size_t o = (size_t)rc * DI + (size_t)(head * DH + d) * 64 + sc;
                const bf16x8 kv = kvr[i]; float f[8];
#pragma unroll
                for (int q = 0; q < 8; ++q) f[q] = bf2f((bf16_t)kv[q]);
                u32x4 a, bb;
#pragma unroll
                for (int q = 0; q < 4; ++q) { a[q] = pack2(f[2 * q] * w0[2 * q], f[2 * q + 1] * w0[2 * q + 1]); bb[q] = pack2(f[2 * q] * w1[2 * q], f[2 * q + 1] * w1[2 * q + 1]); }
                *(u32x4*)(KTW + o) = a; *(u32x4*)(KTW + (size_t)NTOK * DI + o) = bb;
                float s0 = 0.f, s1 = 0.f;
#pragma unroll
                for (int q = 0; q < 8; ++q) { s0 += f[q] * w0[q]; s1 += f[q] * w1[q]; }
                s0 += DPP_F(s0, 0xB1); s1 += DPP_F(s1, 0xB1); s0 += DPP_F(s0, 0x4E); s1 += DPP_F(s1, 0x4E); s0 += DPP_F(s0, 0x141); s1 += DPP_F(s1, 0x141);
                if ((c.tid & 7) == 0) { float* KS = (float*)(c.ws + WS_MIX + MX_KS); KS[((((size_t)0 * BATCH + b) * NH + head) * ML_NCH + k) * DH + d] = s0; KS[((((size_t)1 * BATCH + b) * NH + head) * ML_NCH + k) * DH + d] = s1; } }
        }
        if (!isctx) {
            f32x4 sacc[2] = {(f32x4){0.f, 0.f, 0.f, 0.f}, (f32x4){0.f, 0.f, 0.f, 0.f}};
            { const unsigned lo = (unsigned)(fr * ML_PP + 16 * fq); const unsigned char* qb = ldsQK + (tt * 16) * ML_PP; const unsigned char* kb0 = ldsQK + 64 * ML_PP + ((2 * nh2) * 16) * ML_PP;
#pragma unroll
              for (int kk = 0; kk < KD; ++kk) { const bf16x8 qa = ldo(qb + kk * 64, lo); sacc[0] = mfma16(qa, ldo(kb0 + kk * 64, lo), sacc[0]); sacc[1] = mfma16(qa, ldo(kb0 + 16 * ML_PP + kk * 64, lo), sacc[1]); } }
#pragma unroll
            for (int dr = 0; dr < 2; ++dr)
#pragma unroll
                for (int n = 0; n < 2; ++n) { const int s = (2 * nh2 + n) * 16 + fr; const float gs = gG[dr * 64 + s], is_ = gI[dr * 64 + s];
#pragma unroll
                    for (int j = 0; j < 4; ++j) { const int t = tt * 16 + 4 * fq + j; const bool ok = dr ? (s >= t) : (s <= t);
                        const float pv = ok ? sacc[n][j] * expf(gG[dr * 64 + t] - gs + is_) : 0.f;
                        pt[(dr * 64 + t) * 72 + s] = f2bf(pv);
                        float rs = pv; rs += DPP_F(rs, 0xB1); rs += DPP_F(rs, 0x4E); rs += DPP_F(rs, 0x141); rs += DPP_F(rs, 0x140);
                        if (fr == 0) rsum[((dr * 64 + t) * 2 + nh2) * 2 + n] = rs; } }
            __syncthreads();
            if (c.tid < 128) { const int dr = c.tid >> 6, t = c.tid & 63; const float* r4 = rsum + (dr * 64 + t) * 4;
                ((float*)(c.ws + WS_MIX + MX_RP))[((size_t)dr * NLAT + (rc - NCTX + t)) * NH + head] = (r4[0] + r4[1]) + (r4[2] + r4[3]); }
#pragma unroll
            for (int i = 0; i < 2; ++i) { const int e = c.tid + NT * i, dr = e >> 9, t = (e >> 3) & 63, sc = (e & 7) * 8;
                *(u32x4*)(P + ((((size_t)dr * BATCH + b) * NH + head) * ML_NLC + ci) * 4096 + t * 64 + sc) = *(const u32x4*)(pt + (dr * 64 + t) * 72 + sc); }
        }
    }
    __syncthreads();
}
constexpr int ML_DENQ = 4;
DEV void ml_den_phase(const Ctx& c) {
    static_assert(ML_NLC % ML_DENQ == 0, "den quarters");
    const bf16_t* Q = (const bf16_t*)(c.ws + WS_MIX + MX_Q); const float* GQ = (const float*)(c.ws + WS_MIX + MX_GQ); const float* DEC = (const float*)(c.ws + WS_MIX + MX_DEC);
    const float* RP = (const float*)(c.ws + WS_MIX + MX_RP); const float* KS = (const float*)(c.ws + WS_MIX + MX_KS); float* DEN = (float*)(c.ws + WS_MIX + MX_DEN);
    float* nst = (float*)c.lds;
    constexpr int EPL = DH / 64;
    for (int u = c.blk; u < BATCH * NH * 2 * ML_DENQ; u += c.nblk) {
        const int qt = u % ML_DENQ, dr = (u / ML_DENQ) & 1, head = (u / (2 * ML_DENQ)) % NH, b = u / (2 * NH * ML_DENQ);
        const size_t cbase = (((size_t)dr * BATCH + b) * NH + head) * ML_NCH;
        __syncthreads();
        for (int d = c.tid; d < DH; d += NT) { float n = 0.f;
#pragma unroll
            for (int st = 0; st < ML_NCH; ++st) {         const bool isctx = st < ML_NCC; const int ci = isctx ? (dr ? ML_NCC - 1 - st : st) : (dr ? ML_NLC - 1 - (st - ML_NCC) : st - ML_NCC); const int kphys = isctx ? ci : ML_NCC + ci;
                if (!isctx) nst[ci * DH + d] = n;
                n = DEC[cbase + kphys] * n + KS[(cbase + kphys) * DH + d]; } }
        __syncthreads();
        constexpr int ROWS = (ML_NLC / ML_DENQ) * 64;
        const int row0 = NCTX + b * SEQ + qt * ROWS;
#pragma unroll 4
        for (int r = c.wave; r < ROWS; r += NT / 64) { const int row = row0 + r, ci = (qt * ROWS + r) >> 6; const bf16_t* qr = Q + (size_t)row * DI + head * DH + c.lane * EPL; const float* nl = nst + ci * DH + c.lane * EPL; float a = 0.f;
            if (EPL == 8) { const bf16x8 qv = ld8(qr); const f32x4 n0 = *(const f32x4*)nl, n1 = *(const f32x4*)(nl + 4);
#pragma unroll
                for (int q = 0; q < 4; ++q) a += bf2f((bf16_t)qv[q]) * n0[q] + bf2f((bf16_t)qv[4 + q]) * n1[q]; }
            else {
#pragma unroll
                for (int q = 0; q < EPL; ++q) a += bf2f(qr[q]) * nl[q]; }
            a = wave_sum(a);
            if (c.lane == 0) { const size_t lrow = (size_t)(row - NCTX); DEN[((size_t)dr * NLAT + lrow) * NH + head] = RP[((size_t)dr * NLAT + lrow) * NH + head] + GQ[((size_t)dr * NH + head) * NTOK + row] * a; } }
    }
    __syncthreads();
}
constexpr int ML_ES = 64, ML_ET = ML_ES / 16, ML_ETW = ML_ET / 2;
constexpr int ML_NSL = DH / ML_ES;
constexpr int ML_CP = DH * 2 + 16;
constexpr int ML_CBUF = ML_ES * ML_CP, ML_QBUF = 64 * ML_CP;
template <int ABL>
DEV void ml_scan_phase(const Ctx& c) {
    const bf16_t* Q = (const bf16_t*)(c.ws + WS_MIX + MX_Q);
    const bf16_t* VT = (const bf16_t*)(c.ws + WS_MIX + MX_VT);
    const float* GQ = (const float*)(c.ws + WS_MIX + MX_GQ); const float* DEC = (const float*)(c.ws + WS_MIX + MX_DEC);
    const bf16_t* P = (const bf16_t*)(c.ws + WS_MIX + MX_P);
    bf16_t* NUM = (bf16_t*)(c.ws + WS_MIX + MX_NUM); float* DEN = (float*)(c.ws + WS_MIX + MX_NUM);
    unsigned char* ldsC = c.lds; unsigned char* ldsQ = c.lds + ML_CBUF; unsigned char* ldsV = c.lds + ML_CBUF + ML_QBUF;
    const int fr = c.lane & 15, fq = c.lane >> 4, wave = c.wave, tt = wave >> 1, nh2 = wave & 1;
    constexpr int KD = DH / 32, DTW = DH / 16 / 8, QPT = DH / 64;
    const int qrow_t = c.tid >> 3, qcol_t = (c.tid & 7) * 8;
    constexpr int NGRP = BATCH * NH * 2;
    const int XC = (c.nblk % 8 == 0 && NGRP % 8 == 0) ? 8 : 1, xcd = c.blk % XC, lblk = c.blk / XC, W = c.nblk / XC;
    for (int id = lblk; id < (NGRP / XC) * ML_NSL; id += W) {
        const int grp = xcd + XC * (id / ML_NSL), sl = id % ML_NSL, dr = grp & 1, head = (grp >> 1) % NH, b = grp / (2 * NH);
        constexpr bool densl = false;
        const bf16_t* KT = (const bf16_t*)(c.ws + WS_MIX + MX_KTW) + (size_t)dr * NTOK * DI;
        f32x4 cacc[DTW][ML_ET];
#pragma unroll
        for (int n = 0; n < DTW; ++n)
#pragma unroll
            for (int m = 0; m < ML_ET; ++m) cacc[n][m] = (f32x4){0.f, 0.f, 0.f, 0.f};
        const rsrc_t rV = mk_rsrc(VT), rK = mk_rsrc(KT), rP = mk_rsrc(P);
#define SBLD(r, v, s) ((ABL == 3) ? (bf16x8){(short)(v), 1, 2, 3, 4, 5, 6, (short)(s)} : bld(r, v, s))
        const unsigned coff = (unsigned)(fr * ML_CP + 16 * fq);
        __syncthreads();
        for (int i = c.tid; i < ML_CBUF / 4; i += NT) ((unsigned*)ldsC)[i] = 0u;
        {
            const bool c0ctx = ML_NCC > 0; const int ci0 = c0ctx ? (dr ? ML_NCC - 1 : 0) : (dr ? ML_NLC - 1 : 0); const int rc0 = (c0ctx ? b * CTX_LEN : NCTX + b * SEQ) + ci0 * 64;
            const bf16_t* vg = VT + (size_t)rc0 * DI + (size_t)(head * DH + sl * ML_ES) * 64 + (c.tid >> 3) * 64 + (c.tid & 7) * 8;
            if (c.tid < ML_ES * 8) *(u32x4*)(ldsV + (c.tid >> 3) * 144 + (c.tid & 7) * 16) = *(const u32x4*)vg; }
        if (ML_NCC == 0) {
            const int ci0 = dr ? ML_NLC - 1 : 0; const bf16_t* qg = Q + (size_t)(NCTX + b * SEQ + ci0 * 64 + qrow_t) * DI + head * DH + qcol_t;
#pragma unroll
            for (int i = 0; i < QPT; ++i) *(u32x4*)(ldsQ + qrow_t * ML_CP + (qcol_t + 64 * i) * 2) = *(const u32x4*)(qg + 64 * i);
        }
        __syncthreads();
#pragma unroll 1
        for (int st = 0; st < ML_NCH; ++st) {
            const bool isctx = st < ML_NCC; const int ci = isctx ? (dr ? ML_NCC - 1 - st : st) : (dr ? ML_NLC - 1 - (st - ML_NCC) : st - ML_NCC);
            const int L = isctx ? CTX_LEN : SEQ; const int r0 = isctx ? b * CTX_LEN : NCTX + b * SEQ; const int rc = r0 + ci * 64; const int kphys = isctx ? ci : ML_NCC + ci;
            const bool nq = (st + 1 < ML_NCH) && (st + 1 >= ML_NCC);
            const int ncq = (st + 1 == ML_NCC) ? (dr ? ML_NLC - 1 : 0) : (dr ? ci - 1 : ci + 1);
            u32x4 qs[QPT];
            if (nq) { const bf16_t* qg = Q + (size_t)(NCTX + b * SEQ + ncq * 64 + qrow_t) * DI + head * DH + qcol_t;
#pragma unroll
                for (int i = 0; i < QPT; ++i) qs[i] = (ABL == 3) ? (u32x4){(unsigned)i, 1u, 2u, 3u} : *(const u32x4*)(qg + 64 * i); }
            const bool nv = st + 1 < ML_NCH; u32x4 vs = {0u, 0u, 0u, 0u};
            if (nv && c.tid < ML_ES * 8) { const int s1 = st + 1; const bool c1 = s1 < ML_NCC; const int ci1 = c1 ? (dr ? ML_NCC - 1 - s1 : s1) : (dr ? ML_NLC - 1 - (s1 - ML_NCC) : s1 - ML_NCC); const int rc1 = (c1 ? b * CTX_LEN : NCTX + b * SEQ) + ci1 * 64;
                vs = (ABL == 3) ? (u32x4){1u, 2u, 3u, 4u} : *(const u32x4*)(VT + (size_t)rc1 * DI + (size_t)(head * DH + sl * ML_ES) * 64 + (c.tid >> 3) * 64 + (c.tid & 7) * 8); }
            bf16x8 vt[ML_ET][2], kt[DTW][2];
            const unsigned voff = (unsigned)(fr * 144 + 16 * fq);
            const float dec = DEC[(((size_t)dr * BATCH + b) * NH + head) * ML_NCH + kphys];
            const unsigned soff = (unsigned)((fr * 64 + 8 * fq) * 2), tstep = (unsigned)(16 * 64 * 2);
            const unsigned kb = (unsigned)(((size_t)rc * DI + (size_t)(head * DH + wave * DTW * 16) * 64) * 2);
#pragma unroll
            for (int ks = 0; ks < 2; ++ks) {
#pragma unroll
                for (int m = 0; m < ML_ET; ++m) vt[m][ks] = ldo(ldsV + (m * 16) * 144 + ks * 64, voff);
#pragma unroll
                for (int n = 0; n < DTW; ++n) kt[n][ks] = SBLD(rK, soff, kb + n * tstep + ks * 64);
            }
            if (!isctx) {
                const unsigned pb = (unsigned)((((((size_t)dr * BATCH + b) * NH + head) * ML_NLC + ci) * 4096 + (tt * 16) * 64) * 2);
                const unsigned poff = (unsigned)((fr * 64 + 8 * fq) * 2);
                const bf16x8 p0 = SBLD(rP, poff, pb), p1 = SBLD(rP, poff, pb + 64);
                bf16x8 vi[ML_ETW][2];
#pragma unroll
                for (int n = 0; n < ML_ETW; ++n) { const int m = nh2 * ML_ETW + n; vi[n][0] = ldo(ldsV + (m * 16) * 144, voff); vi[n][1] = ldo(ldsV + (m * 16) * 144 + 64, voff); }
                const float gq = GQ[((size_t)dr * NH + head) * NTOK + rc + tt * 16 + fr];
                f32x4 iacc[ML_ETW], oacc[ML_ETW];
#pragma unroll
                for (int n = 0; n < ML_ETW; ++n) { iacc[n] = (f32x4){0.f, 0.f, 0.f, 0.f}; oacc[n] = iacc[n]; }
                const unsigned char* cb0 = ldsC + (nh2 * ML_ETW * 16) * ML_CP; const unsigned char* qb0 = ldsQ + (tt * 16) * ML_CP;
#pragma unroll
                for (int kk = 0; kk < (ABL == 4 ? 1 : KD); ++kk) { const bf16x8 qa = ldo(qb0 + kk * 64, coff);
#pragma unroll
                    for (int n = 0; n < ML_ETW; ++n) iacc[n] = mfma16(ldo(cb0 + (n * 16) * ML_CP + kk * 64, coff), qa, iacc[n]);
                    if ((kk & 3) == 3) SCHED_FENCE(); }
#pragma unroll
                for (int n = 0; n < ML_ETW; ++n) { oacc[n] = mfma16(vi[n][0], p0, oacc[n]); oacc[n] = mfma16(vi[n][1], p1, oacc[n]); }
#pragma unroll
                for (int n = 0; n < ML_ETW; ++n) { const int e0 = (nh2 * ML_ETW + n) * 16 + 4 * fq; const size_t lrow = (size_t)(rc - NCTX + tt * 16 + fr);
                    const f32x4 val = oacc[n] + iacc[n] * gq;
                    u32x2 w; w[0] = pack2(val[0], val[1]); w[1] = pack2(val[2], val[3]);
                    if (ABL > 0) { if (w[0] == 0x12345678u) *(u32x2*)(NUM) = w; }
                    else *(u32x2*)(NUM + ((size_t)dr * NLAT + lrow) * DI + head * DH + sl * ML_ES + e0) = w; }
            }
            if (ABL != 2) __syncthreads();
            if (nq) {
#pragma unroll
                for (int i = 0; i < QPT; ++i) *(u32x4*)(ldsQ + qrow_t * ML_CP + (qcol_t + 64 * i) * 2) = qs[i]; }
            if (nv && c.tid < ML_ES * 8) *(u32x4*)(ldsV + (c.tid >> 3) * 144 + (c.tid & 7) * 16) = vs;
#pragma unroll
            for (int n = 0; n < DTW; ++n)
#pragma unroll
                for (int m = 0; m < ML_ET; ++m) { f32x4 a = cacc[n][m] * dec; a = mfma16(kt[n][0], vt[m][0], a); a = mfma16(kt[n][1], vt[m][1], a); cacc[n][m] = a;
                    u32x2 w; w[0] = pack2(a[0], a[1]); w[1] = pack2(a[2], a[3]);
                    *(u32x2*)(ldsC + (m * 16 + fr) * ML_CP + ((wave * DTW + n) * 16 + 4 * fq) * 2) = w; }
            if (ABL != 2) __syncthreads();
        }
    }
}
#undef SBLD
DEV void ml_finish_phase(const Ctx& c, int mj) {
    const bf16_t* NUM = (const bf16_t*)(c.ws + WS_MIX + MX_NUM); const float* DEN = (const float*)(c.ws + WS_MIX + MX_DEN);
    const bf16_t* XC = (const bf16_t*)(c.ws + WS_MIX + MX_XC); const bf16_t* XMZ = (const bf16_t*)(c.ws + WS_MIX + MX_XMZ); bf16_t* HB2 = (bf16_t*)(c.ws + WS_MIX + MX_HB2);
    const float* og = c.p->in[I_MLONG] + (size_t)mj * DI; const float* sk = c.p->in[I_MLSKIP] + (size_t)mj * DI;
    const int nw = c.nblk * (NT / 64), w0 = c.blk * (NT / 64) + c.wave;
    constexpr int EPL = DH / 64;
    if (EPL == 8) {
        bf16x8 a, b, x, z, an, bn, xn, zn; float e0 = 1.f, e1 = 1.f, e0n = 1.f, e1n = 1.f;
        auto issue = [&](int u, bf16x8& pa, bf16x8& pb, bf16x8& px, bf16x8& pz, float& q0, float& q1) { const int lrow = u / NH, head = u % NH, co = head * DH + c.lane * EPL; const size_t trow = (size_t)(NCTX + lrow);
            pa = __builtin_nontemporal_load((const bf16x8*)(NUM + (size_t)lrow * DI + co)); pb = __builtin_nontemporal_load((const bf16x8*)(NUM + ((size_t)NLAT + lrow) * DI + co));        px = ld8(XC + trow * DI + co); pz = ld8(XMZ + trow * 2 * DI + DI + co);
            q0 = DEN[(size_t)lrow * NH + head]; q1 = DEN[((size_t)NLAT + lrow) * NH + head]; };
        if (w0 < NLAT * NH) issue(w0, a, b, x, z, e0, e1);
        for (int u = w0; u < NLAT * NH; u += nw) {
            if (u + nw < NLAT * NH) issue(u + nw, an, bn, xn, zn, e0n, e1n);
            const int lrow = u / NH, head = u % NH, co = head * DH + c.lane * EPL;
            const f32x4 g0 = *(const f32x4*)(og + co), g1 = *(const f32x4*)(og + co + 4), s0 = *(const f32x4*)(sk + co), s1 = *(const f32x4*)(sk + co + 4);
            const float i0 = 1.f / fmaxf(fabsf(e0), 1.f), i1 = 1.f / fmaxf(fabsf(e1), 1.f);
            float h[8]; float s = 0.f;
#pragma unroll
            for (int q = 0; q < 8; ++q) { h[q] = bf2f((bf16_t)a[q]) * i0 + bf2f((bf16_t)b[q]) * i1; s += h[q]; }
            const float mu = wave_sum(s) / (float)DH; float vs = 0.f;
#pragma unroll
            for (int q = 0; q < 8; ++q) { h[q] -= mu; vs += h[q] * h[q]; }
            const float rinv = rsqrtf(wave_sum(vs) / (float)DH + EPS);
            float o[8];
#pragma unroll
            for (int q = 0; q < 8; ++q) o[q] = (h[q] * rinv * (q < 4 ? g0[q & 3] : g1[q & 3]) + (q < 4 ? s0[q & 3] : s1[q & 3]) * bf2f((bf16_t)x[q])) * siluf_(bf2f((bf16_t)z[q]));
            u32x4 w; w[0] = pack2(o[0], o[1]); w[1] = pack2(o[2], o[3]); w[2] = pack2(o[4], o[5]); w[3] = pack2(o[6], o[7]); *(u32x4*)(HB2 + (size_t)lrow * DI + co) = w;
            a = an; b = bn; x = xn; z = zn; e0 = e0n; e1 = e1n;
        }
    } else {
        for (int u = w0; u < NLAT * NH; u += nw) {
            const int lrow = u / NH, head = u % NH; const int co = head * DH + c.lane * EPL;
            const float d0 = fmaxf(fabsf(DEN[(size_t)lrow * NH + head]), 1.f), d1 = fmaxf(fabsf(DEN[((size_t)NLAT + lrow) * NH + head]), 1.f);
            const size_t trow = (size_t)(NCTX + lrow);
            float h[EPL]; float s = 0.f;
#pragma unroll
            for (int q = 0; q < EPL; ++q) { h[q] = bf2f(NUM[(size_t)lrow * DI + co + q]) / d0 + bf2f(NUM[((size_t)NLAT + lrow) * DI + co + q]) / d1; s += h[q]; }
            const float mu = wave_sum(s) / (float)DH; float vs = 0.f;
#pragma unroll
            for (int q = 0; q < EPL; ++q) { h[q] -= mu; vs += h[q] * h[q]; }
            const float rinv = rsqrtf(wave_sum(vs) / (float)DH + EPS);
#pragma unroll
            for (int q = 0; q < EPL; ++q) { const float hn = h[q] * rinv * og[co + q]; const float xc = bf2f(XC[trow * DI + co + q]); const float z = bf2f(XMZ[trow * 2 * DI + DI + co + q]);
                HB2[(size_t)lrow * DI + co + q] = f2bf((hn + sk[co + q] * xc) * siluf_(z)); }
        }
    }
}

constexpr int PH_PER_LAYER = 13;
constexpr int N_PHASES = 2 + DEPTH * PH_PER_LAYER + 1;
constexpr bool phase_exists(int ph) {
    if (ph < 2 || ph == N_PHASES - 1) return true;
    const int layer = (ph - 2) / PH_PER_LAYER, s = (ph - 2) % PH_PER_LAYER, kind = layer % 3;
    if (s >= 9) return true;
    return kind == 0 ? s <= 5 : (kind == 1 ? s <= 3 : s <= 8);
}


constexpr bool probe_repeat(int ph) {
    if (PROBE_GROUP == 0) return false;
    if (ph < 2) return PROBE_GROUP == 7 || (PROBE_GROUP == 11 && ph == 1);
    if (ph == N_PHASES - 1) return false;
    const int layer = (ph - 2) / PH_PER_LAYER, s = (ph - 2) % PH_PER_LAYER, kind = layer % 3;
    if (PROBE_GROUP == 1) return s == 11 || s == 12;
    if (PROBE_GROUP == 2) return kind == 1 && s == 1;
    if (PROBE_GROUP == 3) return kind == 2 && (s == 4 || s == 5 || s == 6);
    if (PROBE_GROUP == 4) return kind == 0 && s == 3;
    if (PROBE_GROUP == 33) return kind == 2 && s == 4;
    if (PROBE_GROUP == 34) return kind == 2 && s == 5;
    if (PROBE_GROUP == 35) return kind == 2 && s == 1;
    if (PROBE_GROUP == 36) return kind == 0 && s == 1;
    if (PROBE_GROUP == 21) return kind == 0 && s == 2;
    if (PROBE_GROUP == 22) return kind == 0 && s == 4;
    if (PROBE_GROUP == 23) return kind == 2 && s == 2;
    if (PROBE_GROUP == 24) return kind == 2 && s == 3;
    if (PROBE_GROUP == 25) return kind == 2 && s == 7;
    if (PROBE_GROUP == 26) return s == 10;
    if (PROBE_GROUP == 13) return kind == 2 && (s == 4 || s == 5);
    if (PROBE_GROUP == 14) return kind == 2 && s == 6;
    if (PROBE_GROUP == 12) return (kind == 0 && s == 5) || (kind == 1 && s == 3) || (kind == 2 && s == 8);
    if (PROBE_GROUP == 6) return (kind == 0 && s == 1) || (kind == 2 && s == 1);
    if (PROBE_GROUP == 8) return (kind == 0 && (s == 2 || s == 4)) || (kind == 2 && (s == 2 || s == 3 || s == 7)) || s == 10;
    return false;
}
template <int PH>
DEV void phase_body(Ctx& c) {
    const Params& P = *c.p;
    if constexpr (PH == 0) {
        mods_phase(c);
        auto rot = [&](int first) { return (c.blk + c.nblk - first % c.nblk) % c.nblk; };
        transpose_job<0>(c, P.in[I_HYWIN], (bf16_t*)(P.ws + WS_WHYIN), DM, 3 * DM, 2, (size_t)3 * DM * DM, 0);
        transpose_job<0>(c, P.in[I_HYWOUT], (bf16_t*)(P.ws + WS_WHYOUT), DM, DM, 2, (size_t)DM * DM, 0, rot(c.nblk / 2), c.nblk);
        transpose_job<2>(c, P.in[I_S5W1], (bf16_t*)(P.ws + WS_WS5), DM, DM, 1, 0, 0);
        transpose_job<3>(c, P.in[I_S5W2], (bf16_t*)(P.ws + WS_WS5), DM, DM, 1, 0, 0, rot(c.nblk / 4), c.nblk);
        transpose_job<0>(c, P.in[I_MLWUP], (bf16_t*)(P.ws + WS_WMLUP), DM, 2 * DI, 1, 0, 0);
        transpose_job<0>(c, P.in[I_MLWDN], (bf16_t*)(P.ws + WS_WMLDN), DI, DM, 1, 0, 0, rot(c.nblk / 2), c.nblk);
        transpose_job<1>(c, P.in[I_WGU], (bf16_t*)(P.ws + WS_WGU), DM, 2 * FF, 2 * NE, (size_t)2 * FF * DM, 0);
        transpose_job<0>(c, P.in[I_WDN], (bf16_t*)(P.ws + WS_WDN), FF, DM, 2 * NE, (size_t)DM * FF, 0);
        gatew_job(c);
        { float* RWT = (float*)(P.ws + WS_RWT); const float* rw = P.in[I_RW];
          for (int i = c.blk * NT + c.tid; i < DEPTH * NE * DM; i += c.nblk * NT) { const int l = i / (NE * DM), e = (i / DM) % NE, k = i % DM; RWT[i] = rw[((size_t)l * DM + k) * NE + e]; } }
        filter_gen_job(c, 0, 0, SEQ); filter_gen_job(c, 1, 0, CTX_LEN); filter_gen_job(c, 2, 1, SEQ);
#if PROBE_GROUP == 9
        transpose_job<1>(c, P.in[I_WGU], (bf16_t*)(P.ws + WS_WGU), DM, 2 * FF, DEPTH * NE, (size_t)2 * FF * DM, 0);
        transpose_job<0>(c, P.in[I_WDN], (bf16_t*)(P.ws + WS_WDN), FF, DM, DEPTH * NE, (size_t)DM * FF, 0);
#endif
#if PROBE_GROUP == 10
        filter_gen_job(c, 0, 0, SEQ); filter_gen_job(c, 1, 0, CTX_LEN); filter_gen_job(c, 2, 1, SEQ);
        mods_phase(c);
#endif
    } else if constexpr (PH == 1) {
        mods_reduce(c);
        filter_fin_job(c, 0, 0, SEQ); filter_fin_job(c, 1, 0, CTX_LEN); filter_fin_job(c, 2, 1, SEQ);
    } else if constexpr (PH == N_PHASES - 1) {
        final_phase(c);
    } else {
        constexpr int layer = (PH - 2) / PH_PER_LAYER, s = (PH - 2) % PH_PER_LAYER, kind = layer % 3, j = layer / 3;
        constexpr bool ctx_live = layer < 2;
        constexpr int row_lo = (layer == 3) ? NCTX : 0;
        constexpr int out_lo = ctx_live ? 0 : NCTX;
        const float* modbase = (const float*)(P.ws + WS_MOD) + (size_t)layer * NMODR * 6 * DM;
        float* X = (float*)(P.ws + WS_X);
        constexpr int comb = layer > 0 ? layer - 1 : -1;
        if constexpr (s >= 9) {
            if constexpr (s == 9) moe_route_phase(c, layer, out_lo, NTOK);
            else if constexpr (s == 10) moe_scatter_phase(c, layer, out_lo, NTOK);
            else if constexpr (s == 11) moe_gemm1_phase(c, layer);
            else moe_gemm2_phase(c, layer);
        } else if constexpr (kind == 0) {
            constexpr int tile_lo = row_lo / 64, tile_hi = NTOK / 64;
            if constexpr (s == 0) { c.x_from_inputs = (layer == 0); norm1_phase<0>(c, layer, row_lo, NTOK, comb, nullptr); c.x_from_inputs = false; }
            else if constexpr (s == 1) { const bf16_t* W = (const bf16_t*)(P.ws + WS_WHYIN) + (size_t)j * 3 * DM * DM; const float* bi = P.in[I_HYBIN] + (size_t)j * 3 * DM; bf16_t* U = (bf16_t*)(P.ws + WS_MIX + MX_U);
                gemm_dense_phase(c, (const bf16_t*)(P.ws + WS_HB), row_lo, NTOK - row_lo, W, 3 * DM, DM, EpiBf16{U, 3 * DM, bi}); }
            else if constexpr (s == 2) hy_conv_phase(c, j, tile_lo, tile_hi);
            else if constexpr (s == 3) { if constexpr (layer == 0) { hy_longconv_job<SEQ>(c, 0, BATCH); hy_longconv_job<CTX_LEN>(c, 1, 0); } else hy_longconv_job<SEQ>(c, 2, BATCH); }
            else if constexpr (s == 4) hy_gate_phase(c, tile_lo, tile_hi);
            else { const bf16_t* W = (const bf16_t*)(P.ws + WS_WHYOUT) + (size_t)j * DM * DM; const float* bo = P.in[I_HYBOUT] + (size_t)j * DM;
                gemm_dense_phase(c, (const bf16_t*)(P.ws + WS_HB), row_lo, NTOK - row_lo, W, DM, DM, EpiResid{X, bo, modbase, false, c.pscale, layer == 0 ? P.in : nullptr}); }
        } else if constexpr (kind == 1) {
            if constexpr (s == 0) norm1_phase<0>(c, layer, 0, NTOK, comb, nullptr);
            else if constexpr (s == 1) {
                const int busy = S5G * 2 < c.nblk ? S5G * 2 : c.nblk;
                if (c.blk < busy || busy == c.nblk) s5_scan_phase(c);
                if (busy == c.nblk || c.blk >= busy) { const int b2 = busy == c.nblk ? c.blk : c.blk - busy, n2 = busy == c.nblk ? c.nblk : c.nblk - busy;
                    transpose_job<1>(c, P.in[I_WGU] + (size_t)2 * NE * DM * 2 * FF, (bf16_t*)(P.ws + WS_WGU) + (size_t)2 * NE * 2 * FF * DM, DM, 2 * FF, 2 * NE, (size_t)2 * FF * DM, 0, b2, n2);
                    transpose_job<0>(c, P.in[I_WDN] + (size_t)2 * NE * FF * DM, (bf16_t*)(P.ws + WS_WDN) + (size_t)2 * NE * DM * FF, FF, DM, 2 * NE, (size_t)DM * FF, 0, b2, n2); } }
            else if constexpr (s == 2) s5_finish_phase(c, j);
            else { const float* b1 = P.in[I_S5B1] + (size_t)j * DM; const float* b2 = P.in[I_S5B2] + (size_t)j * DM;
                gemm_dense_phase(c, (const bf16_t*)(P.ws + WS_HB), 0, NTOK, (const bf16_t*)(P.ws + WS_WS5), 2 * DM, DM, EpiGlu{X, b1, b2, modbase, c.pscale}); }
        } else {
            if constexpr (s == 0) norm1_phase<2>(c, layer, 0, NTOK, comb, nullptr);
            else if constexpr (s == 1) { bf16_t* XMZ = (bf16_t*)(P.ws + WS_MIX + MX_XMZ);
                gemm_dense_phase(c, (const bf16_t*)(P.ws + WS_HB), 0, NTOK, (const bf16_t*)(P.ws + WS_WMLUP), 2 * DI, DM, EpiBf16{XMZ, 2 * DI, nullptr}); }
            else if constexpr (s == 2) ml_qkv_phase(c, j);
            else if constexpr (s == 3) ml_gates_phase(c, j);
            else if constexpr (s == 4) ml_prep_phase(c);
            else if constexpr (s == 5) ml_den_phase(c);
            else if constexpr (s == 6) { if (c.pscale == 0.f) ml_scan_phase<PROBE_ABL>(c); else ml_scan_phase<0>(c); }
            else if constexpr (s == 7) ml_finish_phase(c, j);
            else gemm_dense_phase(c, (const bf16_t*)(P.ws + WS_MIX + MX_HB2) - (size_t)NCTX * DI, NCTX, NLAT, (const bf16_t*)(P.ws + WS_WMLDN), DM, DI, EpiResid{X, nullptr, modbase, true, c.pscale, nullptr});
        }
    }
}

#ifndef CPU_EMU
#define GRID_SYNC() do { if (fused) xcd_barrier(bar); } while (0)
#else
#define GRID_SYNC() do { } while (0)
#endif
#ifdef DIAG_PHASE
#define PHASE_ON(PH) ((PH) == DIAG_PHASE)
#else
#define PHASE_ON(PH) true
#endif

__global__ void __launch_bounds__(NT, 2) fwd_kernel(Params P) {
#ifdef CPU_EMU
    unsigned char* lds = emu::T.blk->lds;
#else
    extern __shared__ __attribute__((aligned(16))) unsigned char lds[];
#endif
    Ctx c; c.p = &P; c.ws = P.ws; c.lds = (unsigned char*)lds; c.tid = threadIdx.x; c.lane = c.tid & 63; c.wave = UNIFORM(c.tid >> 6); c.nblk = gridDim.x; c.blk = blockIdx.x; c.pscale = 1.f; c.x_from_inputs = false;
#ifndef CPU_EMU
    XcdBarrier bar; bar.bar = nullptr; bar.x = 0; bar.st = nullptr;
    const bool fused = (P.ph_hi - P.ph_lo) > 1;
    if (fused) {
        if (c.tid < 4) ((volatile LAS unsigned*)(lds + LDS_BYTES - 16))[c.tid] = 0u;
        __syncthreads();
        bar = xcd_barrier_post((unsigned*)(P.ws + WS_CTL), (volatile LAS unsigned*)(lds + LDS_BYTES - 16));
    }
#endif
    const int lo = P.ph_lo, hi = P.ph_hi;
#define RUN(PH) if constexpr (phase_exists(PH) && PHASE_ON(PH)) { if (lo <= (PH) && (PH) < hi) { phase_body<PH>(c); if ((PH) + 1 < hi) GRID_SYNC(); \
        if constexpr (probe_repeat(PH)) { c.pscale = 0.f; phase_body<PH>(c); GRID_SYNC(); c.pscale = 1.f; } } }
    RUN(0) RUN(1)
    RUN(2) RUN(3) RUN(4) RUN(5) RUN(6) RUN(7) RUN(8) RUN(9) RUN(10) RUN(11) RUN(12) RUN(13)
    RUN(14) RUN(15) RUN(16) RUN(17) RUN(18) RUN(19) RUN(20) RUN(21) RUN(22) RUN(23) RUN(24) RUN(25)
    RUN(26) RUN(27) RUN(28) RUN(29) RUN(30) RUN(31) RUN(32) RUN(33) RUN(34) RUN(35) RUN(36) RUN(37)
    RUN(38) RUN(39) RUN(40) RUN(41) RUN(42) RUN(43) RUN(44) RUN(45) RUN(46) RUN(47) RUN(48) RUN(49)
    RUN(50) RUN(51) RUN(52) RUN(53) RUN(54)
    static_assert(N_PHASES == 55, "phase list");
#undef RUN
}

extern "C" void kernel_launch(void* const* d_in, const int* in_sizes, int n_in, void* d_out, int out_size, void* d_ws, size_t ws_size, hipStream_t stream) {
    (void)in_sizes; (void)out_size;
    if (n_in != N_IN || ws_size < WS_END) return;
    Params P{};
    for (int i = 0; i < N_IN; ++i) P.in[i] = (const float*)d_in[i];
    P.out = (float*)d_out; P.ws = (unsigned char*)d_ws;
    (void)hipMemsetAsync((char*)d_ws + WS_CTL, 0, CTL_BYTES, stream);
#ifdef CPU_EMU
    int grid = 8; if (getenv("EMU_GRID")) grid = atoi(getenv("EMU_GRID"));
    int plo = 0, phi = N_PHASES; if (getenv("EMU_PH_HI")) phi = atoi(getenv("EMU_PH_HI"));
    for (int ph = plo; ph < phi; ++ph) { Params Q = P; Q.ph_lo = ph; Q.ph_hi = ph + 1; fprintf(stderr, "phase %d\n", ph); emu::run_grid(dim3(grid), dim3(NT), [Q]() { fwd_kernel(Q); }); }
#else
    static int grid = 0;
    if (grid == 0) {
        int dev = 0, cus = 0;
        if (hipGetDevice(&dev) != hipSuccess || hipDeviceGetAttribute(&cus, hipDeviceAttributeMultiprocessorCount, dev) != hipSuccess) { grid = -1; return; }
        if (hipFuncSetAttribute((const void*)fwd_kernel, hipFuncAttributeMaxDynamicSharedMemorySize, LDS_BYTES) != hipSuccess) { grid = -1; return; }
        grid = cus;
    }
    if (grid < 0) return;
#if N_LAUNCH_MODE == 1
    P.ph_lo = 0; P.ph_hi = N_PHASES;
    hipLaunchKernelGGL(fwd_kernel, dim3(grid), dim3(NT), LDS_BYTES, stream, P);
#else
    for (int ph = 0; ph < N_PHASES; ++ph) {
        if (!phase_exists(ph)) continue;
        P.ph_lo = ph; P.ph_hi = ph + 1;
        hipLaunchKernelGGL(fwd_kernel, dim3(grid), dim3(NT), LDS_BYTES, stream, P);
    }
#endif
#endif
}
```
